# Optimizing an MI355X kernel written in HIP

```python
import math
import jax, jax.numpy as jnp
from jax import lax
import numpy as np

D_MODEL = 1024
BATCH = 16
SEQ = 2048
DEPTH = 4

GRID_W = 64
CTX_LEN = 256
N_MIXERS = 2
EPS = 1e-6

HY_SHORT_K = 3
HY_EMB_BANDS = 16
HY_EMB_DIM = 1 + 2 * HY_EMB_BANDS
HY_FILTER_HIDDEN = 64
HY_INNER_MLPS = 2
HY_DECAY_TARGET = 1e-2
HY_FAST_DECAY_PCT = 0.3
HY_SLOW_DECAY_PCT = 1.5

MLA_HEADS = D_MODEL // 128
MLA_NOPE = 128
MLA_ROPE = 64
MLA_QK = MLA_NOPE + MLA_ROPE
MLA_V = 128
MLA_Q_LORA = 384
MLA_KV_LORA = 256
ROPE_BASE = 10000.0
Q_BLOCK = 128
SOFTMAX_SCALE = MLA_QK ** -0.5

N_EXPERTS = 16
N_GROUPS = 4
EXPERTS_PER_GROUP = N_EXPERTS // N_GROUPS
TOPK_GROUPS = 1
TOP_K = 2
D_EXPERT = 512
D_SHARED = 512

kernel_name = "hybrid_hyena_mla_grouped_moe_dit"

F32 = jnp.float32


def rmsnorm(x, g):
    xf = x.astype(F32)
    y = xf * lax.rsqrt(jnp.mean(xf * xf, axis=-1, keepdims=True) + EPS)
    return (y * g.astype(F32)).astype(x.dtype)


def modulate(h, shift, scale):
    return h * (1.0 + scale) + shift


def short_conv3(u, w, b):
    up = jnp.pad(u, ((0, 0), (1, 1), (0, 0)))
    return up[:, :-2] * w[0] + up[:, 1:-1] * w[1] + up[:, 2:] * w[2] + b


def hyena_filter(L, w1, b1, w2, b2, w3, freq):
    t_norm = jnp.linspace(0.0, 1.0, L, dtype=F32)[:, None]
    pos = jnp.arange(L, dtype=F32)[:, None]
    bands = jnp.linspace(1e-4, HY_EMB_BANDS - 1, HY_EMB_BANDS, dtype=F32)[None, :]
    ang = 2.0 * math.pi * bands * pos / L
    z = jnp.concatenate([t_norm, jnp.cos(ang), -jnp.sin(ang)], axis=-1)
    fr = freq.astype(F32)
    h = jnp.sin(fr * (z @ w1.astype(F32) + b1.astype(F32)))
    for m in range(HY_INNER_MLPS):
        h = jnp.sin(fr * (h @ w2[m].astype(F32) + b2[m].astype(F32)))
    h = (h @ w3.astype(F32)).reshape(L, 2, D_MODEL)
    max_decay = math.log(HY_DECAY_TARGET) / HY_FAST_DECAY_PCT
    min_decay = math.log(HY_DECAY_TARGET) / HY_SLOW_DECAY_PCT
    deltas = jnp.linspace(min_decay, max_decay, D_MODEL, dtype=F32)
    decay = jnp.exp(-t_norm * jnp.abs(deltas))
    h = h * decay[:, None, :]
    h_fwd, h_bwd = h[:, 0], h[:, 1]
    k = jnp.concatenate([h_fwd, jnp.zeros((1, D_MODEL), F32), h_bwd[1:][::-1]], axis=0)
    return k / jnp.sum(jnp.abs(k), axis=0, keepdims=True)


def hyena_mixer(u, in_w, in_b, conv_w, conv_b, fw1, fb1, fw2, fb2, fw3, freq, f_bias, out_w, out_b):
    L = u.shape[1]
    z = short_conv3(u @ in_w + in_b, conv_w, conv_b)
    x0, x1, v = jnp.split(z, 3, axis=-1)
    k = hyena_filter(L, fw1, fb1, fw2, fb2, fw3, freq)
    vg = (v * x1).astype(F32)
    n = 2 * L
    y = jnp.fft.irfft(jnp.fft.rfft(vg, n=n, axis=1) * jnp.fft.rfft(k, n=n, axis=0)[None], n=n, axis=1)[:, :L]
    y = y + vg * f_bias.astype(F32)
    y = (x0.astype(F32) * y).astype(u.dtype)
    return y @ out_w + out_b


def axial_rope_angles(L):
    rows = L // GRID_W
    t_row = jnp.repeat(jnp.arange(rows, dtype=F32), GRID_W)
    t_col = jnp.tile(jnp.arange(GRID_W, dtype=F32), rows)
    half = MLA_ROPE // 2
    inv = ROPE_BASE ** (-jnp.arange(0, half, 2, dtype=F32) / half)
    return t_row[:, None] * inv, t_col[:, None] * inv


def rope_1d(x, ang):
    cos = jnp.cos(ang)[None, :, None, :].astype(x.dtype)
    sin = jnp.sin(ang)[None, :, None, :].astype(x.dtype)
    x1, x2 = jnp.split(x, 2, axis=-1)
    return jnp.concatenate([x1 * cos - x2 * sin, x2 * cos + x1 * sin], axis=-1)


def apply_axial_rope(t, angles):
    ang_row, ang_col = angles
    t_nope, t_rope = t[..., :MLA_NOPE], t[..., MLA_NOPE:]
    r_row, r_col = jnp.split(t_rope, 2, axis=-1)
    return jnp.concatenate([t_nope, rope_1d(r_row, ang_row), rope_1d(r_col, ang_col)], axis=-1)


def mla_queries(h, wq_down, q_norm_g, wq_up, q_head_g, angles):
    B, L, _ = h.shape
    q = (rmsnorm(h @ wq_down, q_norm_g) @ wq_up).reshape(B, L, MLA_HEADS, MLA_QK)
    q = rmsnorm(q, q_head_g)
    return q if angles is None else apply_axial_rope(q, angles)


def mla_keys_values(h, wkv_down, kv_norm_g, wkv_up, k_head_g, angles):
    B, L, _ = h.shape
    kv = h @ wkv_down
    c_kv, k_pe = kv[..., :MLA_KV_LORA], kv[..., MLA_KV_LORA:]
    kvu = (rmsnorm(c_kv, kv_norm_g) @ wkv_up).reshape(B, L, MLA_HEADS, MLA_NOPE + MLA_V)
    k_nope, v = kvu[..., :MLA_NOPE], kvu[..., MLA_NOPE:]
    k_pe = jnp.broadcast_to(k_pe[:, :, None, :], (B, L, MLA_HEADS, MLA_ROPE))
    k = rmsnorm(jnp.concatenate([k_nope, k_pe], axis=-1), k_head_g)
    k = k if angles is None else apply_axial_rope(k, angles)
    return k, v


def attend(q, k, v):
    s = jnp.einsum('bqhd,bkhd->bhqk', q, k, preferred_element_type=F32) * SOFTMAX_SCALE
    p = jax.nn.softmax(s, axis=-1).astype(v.dtype)
    return jnp.einsum('bhqk,bkhd->bqhd', p, v)


def mla_mixer(h, hc, wq_down, q_norm_g, wq_up, wkv_down, kv_norm_g, wkv_up, q_head_g, k_head_g, wo, need_ctx):
    B, L, _ = h.shape
    angles = axial_rope_angles(L)
    q = mla_queries(h, wq_down, q_norm_g, wq_up, q_head_g, angles)
    k, v = mla_keys_values(h, wkv_down, kv_norm_g, wkv_up, k_head_g, angles)
    kc, vc = mla_keys_values(hc, wkv_down, kv_norm_g, wkv_up, k_head_g, None)
    k_all = jnp.concatenate([k, kc], axis=1)
    v_all = jnp.concatenate([v, vc], axis=1)
    nb = L // Q_BLOCK
    qb = jnp.moveaxis(q.reshape(B, nb, Q_BLOCK, MLA_HEADS, MLA_QK), 1, 0)
    ob = lax.map(lambda qq: attend(qq, k_all, v_all), qb)
    y = jnp.moveaxis(ob, 0, 1).reshape(B, L, MLA_HEADS * MLA_V) @ wo
    if not need_ctx:
        return y, None
    qc = mla_queries(hc, wq_down, q_norm_g, wq_up, q_head_g, None)
    Bc, Lc, _ = hc.shape
    yc = attend(qc, kc, vc).reshape(Bc, Lc, MLA_HEADS * MLA_V) @ wo
    return y, yc


def swiglu(h, w1, w3, w2):
    return (jax.nn.silu(h @ w1) * (h @ w3)) @ w2


def grouped_moe(h, router_w, router_bias, w1, w3, w2, sw1, sw3, sw2):
    N = h.shape[0]
    s = jax.nn.sigmoid(jnp.dot(h, router_w, preferred_element_type=F32))
    sb = (s + router_bias.astype(F32)).reshape(N, N_GROUPS, EXPERTS_PER_GROUP)
    group_score = jnp.sum(lax.top_k(sb, TOP_K)[0], axis=-1)
    _, g_sel = lax.top_k(group_score, TOPK_GROUPS)
    g_mask = jnp.any(g_sel[:, :, None] == jnp.arange(N_GROUPS)[None, None, :], axis=1)
    sb = jnp.where(g_mask[:, :, None], sb, -jnp.inf).reshape(N, N_EXPERTS)
    _, e_sel = lax.top_k(sb, TOP_K)
    w = jnp.take_along_axis(s, e_sel, axis=-1)
    w = w / jnp.sum(w, axis=-1, keepdims=True)
    gates = jnp.sum(jax.nn.one_hot(e_sel, N_EXPERTS, dtype=F32) * w[..., None], axis=1).astype(h.dtype)
    out = swiglu(h, sw1, sw3, sw2)
    for e in range(N_EXPERTS):
        out = out + gates[:, e:e + 1] * swiglu(h, w1[e], w3[e], w2[e])
    return out


def setup_inputs(seed: int = 0) -> dict:
    key = jax.random.key(seed)
    ks = iter(jax.random.split(key, 48))

    def nrm(shape, scale):
        return scale * jax.random.normal(next(ks), shape, F32)

    def gain(shape):
        return 1.0 + 0.1 * jax.random.normal(next(ks), shape, F32)

    D = D_MODEL
    nh = (DEPTH + 1) // 2
    nm = DEPTH // 2
    H, HID = MLA_HEADS, HY_FILTER_HIDDEN
    return {
        "x": nrm((BATCH, SEQ, D), 1.0),
        "c": nrm((BATCH, D), 1.0),
        "ctx": nrm((BATCH, CTX_LEN, D), 1.0),
        "c_ctx": nrm((D,), 1.0),
        "ada_w": nrm((DEPTH, D, 6 * D), 0.5 * D ** -0.5),
        "ada_b": nrm((DEPTH, 6 * D), 0.02),
        "norm_mix_g": gain((DEPTH, D)),
        "norm_ffn_g": gain((DEPTH, D)),
        "hy_in_w": nrm((nh, D, 3 * D), D ** -0.5),
        "hy_in_b": nrm((nh, 3 * D), 0.02),
        "hy_conv_w": nrm((nh, HY_SHORT_K, 3 * D), HY_SHORT_K ** -0.5),
        "hy_conv_b": nrm((nh, 3 * D), 0.02),
        "hy_f_w1": nrm((nh, HY_EMB_DIM, HID), HY_EMB_DIM ** -0.5),
        "hy_f_b1": nrm((nh, HID), 0.1),
        "hy_f_w2": nrm((nh, HY_INNER_MLPS, HID, HID), HID ** -0.5),
        "hy_f_b2": nrm((nh, HY_INNER_MLPS, HID), 0.1),
        "hy_f_w3": nrm((nh, HID, 2 * D), HID ** -0.5),
        "hy_sin_freq": gain((nh, HID)),
        "hy_f_bias": nrm((nh, D), 0.1),
        "hy_out_w": nrm((nh, D, D), D ** -0.5),
        "hy_out_b": nrm((nh, D), 0.02),
        "mla_wq_down": nrm((nm, D, MLA_Q_LORA), D ** -0.5),
        "mla_q_norm_g": gain((nm, MLA_Q_LORA)),
        "mla_wq_up": nrm((nm, MLA_Q_LORA, H * MLA_QK), MLA_Q_LORA ** -0.5),
        "mla_wkv_down": nrm((nm, D, MLA_KV_LORA + MLA_ROPE), D ** -0.5),
        "mla_kv_norm_g": gain((nm, MLA_KV_LORA)),
        "mla_wkv_up": nrm((nm, MLA_KV_LORA, H * (MLA_NOPE + MLA_V)), MLA_KV_LORA ** -0.5),
        "mla_q_head_g": gain((nm, MLA_QK)),
        "mla_k_head_g": gain((nm, MLA_QK)),
        "mla_wo": nrm((nm, H * MLA_V, D), (H * MLA_V) ** -0.5),
        "router_w": nrm((D, N_EXPERTS), D ** -0.5),
        "router_bias": nrm((N_EXPERTS,), 0.01),
        "exp_w1": nrm((DEPTH, N_EXPERTS, D, D_EXPERT), D ** -0.5),
        "exp_w3": nrm((DEPTH, N_EXPERTS, D, D_EXPERT), D ** -0.5),
        "exp_w2": nrm((DEPTH, N_EXPERTS, D_EXPERT, D), D_EXPERT ** -0.5),
        "sh_w1": nrm((DEPTH, D, D_SHARED), D ** -0.5),
        "sh_w3": nrm((DEPTH, D, D_SHARED), D ** -0.5),
        "sh_w2": nrm((DEPTH, D_SHARED, D), D_SHARED ** -0.5),
    }


def reference(x, c, ctx, c_ctx, ada_w, ada_b, norm_mix_g, norm_ffn_g,
              hy_in_w, hy_in_b, hy_conv_w, hy_conv_b, hy_f_w1, hy_f_b1, hy_f_w2, hy_f_b2, hy_f_w3,
              hy_sin_freq, hy_f_bias, hy_out_w, hy_out_b,
              mla_wq_down, mla_q_norm_g, mla_wq_up, mla_wkv_down, mla_kv_norm_g, mla_wkv_up,
              mla_q_head_g, mla_k_head_g, mla_wo,
              router_w, router_bias, exp_w1, exp_w3, exp_w2, sh_w1, sh_w3, sh_w2):
    D = D_MODEL
    xc = ctx
    silu_c = jax.nn.silu(c)
    silu_cc = jax.nn.silu(c_ctx)
    for i in range(DEPTH):
        need_ctx = i < DEPTH - 1
        j = i // N_MIXERS
        mod = (silu_c @ ada_w[i] + ada_b[i])[:, None, :]
        mod_c = silu_cc @ ada_w[i] + ada_b[i]
        sh1, sc1, g1, sh2, sc2, g2 = jnp.split(mod, 6, axis=-1)
        sh1c, sc1c, g1c, sh2c, sc2c, g2c = jnp.split(mod_c, 6, axis=-1)
        h = modulate(rmsnorm(x, norm_mix_g[i]), sh1, sc1)
        hc = modulate(rmsnorm(xc, norm_mix_g[i]), sh1c, sc1c)
        if i % N_MIXERS == 0:
            hp = (hy_in_w[j], hy_in_b[j], hy_conv_w[j], hy_conv_b[j], hy_f_w1[j], hy_f_b1[j],
                  hy_f_w2[j], hy_f_b2[j], hy_f_w3[j], hy_sin_freq[j], hy_f_bias[j], hy_out_w[j], hy_out_b[j])
            y = hyena_mixer(h, *hp)
            yc = hyena_mixer(hc, *hp) if need_ctx else None
        else:
            y, yc = mla_mixer(h, hc, mla_wq_down[j], mla_q_norm_g[j], mla_wq_up[j], mla_wkv_down[j],
                              mla_kv_norm_g[j], mla_wkv_up[j], mla_q_head_g[j], mla_k_head_g[j], mla_wo[j],
                              need_ctx)
        x = x + g1 * y
        h2 = modulate(rmsnorm(x, norm_ffn_g[i]), sh2, sc2)
        ep = (router_w, router_bias, exp_w1[i], exp_w3[i], exp_w2[i], sh_w1[i], sh_w3[i], sh_w2[i])
        if need_ctx:
            xc = xc + g1c * yc
            h2c = modulate(rmsnorm(xc, norm_ffn_g[i]), sh2c, sc2c)
            n_lat = h2.shape[0] * h2.shape[1]
            f = grouped_moe(jnp.concatenate([h2.reshape(-1, D), h2c.reshape(-1, D)], axis=0), *ep)
            x = x + g2 * f[:n_lat].reshape(x.shape)
            xc = xc + g2c * f[n_lat:].reshape(xc.shape)
        else:
            x = x + g2 * grouped_moe(h2.reshape(-1, D), *ep).reshape(x.shape)
    return x
```

```cpp
#include <hip/hip_runtime.h>
#include <hip/hip_bf16.h>
#include <stdint.h>
#include <stdio.h>
#include <type_traits>

typedef __hip_bfloat16 bf16;

constexpr int D = 1024, NB = 16, SEQ = 2048, CTX = 256;
constexpr int NLAT = NB * SEQ, NCTX = NB * CTX, NALL = NLAT + NCTX;
constexpr int NE = 16;
constexpr float EPS = 1e-6f;

__device__ __forceinline__ float bf2f(bf16 v) { return __bfloat162float(v); }
__device__ __forceinline__ bf16 f2bf(float v) { return __float2bfloat16(v); }
__device__ __forceinline__ int tidx(int wv) {
  int t;
  asm volatile("v_mbcnt_lo_u32_b32 %0, -1, 0\n\tv_mbcnt_hi_u32_b32 %0, -1, %0\n\tv_lshl_or_b32 %0, %1, 6, %0" : "=v"(t) : "s"(wv));
  return t;
}
template <int M> __device__ __forceinline__ float swz_xor(float v) {
  static_assert(M >= 1 && M < 32, "ds_swizzle bit mode");
  return __int_as_float(__builtin_amdgcn_ds_swizzle(__float_as_int(v), (M << 10) | 0x1f));
}
__device__ __forceinline__ float wave_sum(float v) {
  v += swz_xor<1>(v); v += swz_xor<2>(v); v += swz_xor<4>(v); v += swz_xor<8>(v); v += swz_xor<16>(v);
  auto rr = __builtin_amdgcn_permlane32_swap(__float_as_uint(v), __float_as_uint(v), false, false);
  return __uint_as_float(rr[0]) + __uint_as_float(rr[1]);
}
__device__ __forceinline__ float wave_max(float v) {
  v = fmaxf(v, swz_xor<1>(v)); v = fmaxf(v, swz_xor<2>(v)); v = fmaxf(v, swz_xor<4>(v)); v = fmaxf(v, swz_xor<8>(v)); v = fmaxf(v, swz_xor<16>(v));
  auto rr = __builtin_amdgcn_permlane32_swap(__float_as_uint(v), __float_as_uint(v), false, false);
  return fmaxf(__uint_as_float(rr[0]), __uint_as_float(rr[1]));
}
template <int M> __device__ __forceinline__ float shfl_xor_c(float v, int lane) {
  if constexpr (M < 32) return swz_xor<M>(v);
  else { auto rr = __builtin_amdgcn_permlane32_swap(__float_as_uint(v), __float_as_uint(v), false, false); return __uint_as_float((lane & 32) ? rr[0] : rr[1]); }
}
__device__ __forceinline__ float silu_f(float v) { return v / (1.f + __expf(-v)); }

struct WS {
  float* mod;
  float* modp;
  bf16* xb;
  bf16* h;
  float* hf;
  float* cs;
  int* cnt;
  int* list;
  int* tok_e;
  float* tok_w;
  bf16* rf;
  float* un;
  bf16* zT;
  bf16* ygT;
  signed char* W_hyin8;
  float* s_hyin;
  signed char* W_mdown8;
  float* s_mdown;
  signed char* W_hyout8;
  float* s_hyout;
  signed char* yg8;
  float* syg;
  bf16* W_qup;
  bf16* W_kvup;
  bf16* W_wo;
  signed char* W13q;
  float* sw13;
  signed char* h8;
  float* sa8;
  uint4* mfrag;
  float* rbias;
  bf16* W2;
  bf16* yg;
  bf16* lat;
  float* ssq;
  bf16* v;
  bf16* q;
  bf16* k;
  bf16* o;
  bf16* hid;
};

struct P {
  const float *x, *c, *ctx, *c_ctx, *ada_w, *ada_b, *norm_mix_g, *norm_ffn_g;
  const float *hy_in_w, *hy_in_b, *hy_conv_w, *hy_conv_b, *hy_f_w1, *hy_f_b1, *hy_f_w2, *hy_f_b2, *hy_f_w3, *hy_sin_freq, *hy_f_bias, *hy_out_w, *hy_out_b;
  const float *mla_wq_down, *mla_q_norm_g, *mla_wq_up, *mla_wkv_down, *mla_kv_norm_g, *mla_wkv_up, *mla_q_head_g, *mla_k_head_g, *mla_wo;
  const float *router_w, *router_bias, *exp_w1, *exp_w3, *exp_w2, *sh_w1, *sh_w3, *sh_w2;
  float* X;
  WS w;
  int layer;
  int j;
  int nrows;
  int slot;
};


__device__ __forceinline__ const float* modrow(const P& p, int tok) {
  int mr = tok < NLAT ? tok / SEQ : 16;
  return p.w.mod + ((size_t)p.layer * 17 + mr) * 6144;
}
using bf16x8 = __attribute__((ext_vector_type(8))) short;
using f32x4 = __attribute__((ext_vector_type(4))) float;
constexpr int SHM_SLOT = 135168 + 16;
constexpr int BK = 64, HT = 128 * 64;
constexpr int GEMM_SHM = 8 * HT * 2;

__device__ __forceinline__ int lds_byte(int r, int c) {
  int st = (r >> 4) * 2 + (c >> 5), rr = r & 15, cc = c & 31, ob = rr * 64 + cc * 2;
  return st * 1024 + (ob ^ (((ob >> 9) & 1) << 5));
}
__device__ __forceinline__ void stage_rc(int b, int& R, int& C) {
  int st = b / 1024, sb = b % 1024, swz = sb ^ (((sb >> 9) & 1) << 5);
  R = (st >> 1) * 16 + swz / 64; C = (st & 1) * 32 + (swz % 64) / 2;
}

struct GemmIO {
  const bf16* A;
  const bf16* B0; const bf16* B1; const bf16* B2;
  int ktper;
  int nt;
  unsigned a4[4];
  unsigned b0;
  unsigned a_h, a_i, b_h, b_i;
};

typedef f32x4 Acc[2][2][4][2];

using i32x4 = __attribute__((ext_vector_type(4))) int;
template <bool SWAP, bool GATHER, int KTPER, bool HALF = false, bool PRE = false, bool I8 = false>
__device__ __forceinline__ void gemm_core(const GemmIO& io, char* shmc, Acc& acc, int wv) {
  bf16* shm = (bf16*)shmc;
#define SA(b, h) (shm + ((b) * 2 + (h)) * HT)
#define SB(b, h) (shm + (4 + (b) * 2 + (h)) * HT)
#define GLDS(gp, lp) __builtin_amdgcn_global_load_lds((const unsigned*)(gp), (__attribute__((address_space(3))) unsigned*)(lp), 16, 0, 0)
#define STAGE_A(TT, P, h, kt) do { _Pragma("unroll") for (int _i = 0; _i < 2; ++_i) \
    GLDS(io.A + (GATHER ? io.a4[(h) * 2 + _i] : io.a4[0] + (h) * io.a_h + _i * io.a_i) + (kt) * BK, (char*)(P) + (TT) * 16 + _i * 8192); } while (0)
#define STAGE_B(TT, P, h, kt) do { int _s = KTPER ? (kt) / (KTPER ? KTPER : 1) : 0; const bf16* _bb = _s == 0 ? io.B0 : (_s == 1 ? io.B1 : io.B2); int _kq = (kt) - _s * KTPER; \
    _Pragma("unroll") for (int _i = 0; _i < 2; ++_i) GLDS(_bb + (io.b0 + (h) * io.b_h + _i * io.b_i) + _kq * BK, (char*)(P) + (TT) * 16 + _i * 8192); } while (0)
#define LDA(dst, b, h) _Pragma("unroll") for (int m = 0; m < 4; ++m) _Pragma("unroll") for (int k = 0; k < 2; ++k) \
    dst[m][k] = *reinterpret_cast<const bf16x8*>((char*)SA(b, h) + lds_byte(wr * 64 + m * 16 + fr, k * 32 + fq * 8))
#define LDB(dst, b, h) _Pragma("unroll") for (int n = 0; n < 2; ++n) _Pragma("unroll") for (int k = 0; k < 2; ++k) \
    dst[n][k] = *reinterpret_cast<const bf16x8*>((char*)SB(b, h) + lds_byte(wc * 32 + n * 16 + fr, k * 32 + fq * 8))
#define MMA1(a_, b_, c_) (I8 ? __builtin_bit_cast(f32x4, __builtin_amdgcn_mfma_i32_16x16x64_i8(__builtin_bit_cast(i32x4, a_), __builtin_bit_cast(i32x4, b_), __builtin_bit_cast(i32x4, c_), 0, 0, 0)) \
                             : __builtin_amdgcn_mfma_f32_16x16x32_bf16(a_, b_, c_, 0, 0, 0))
#define MMA(ai, bj, At, Bt) do { if (HALF && (bj) == 1) break; __builtin_amdgcn_s_setprio(1); \
    _Pragma("unroll") for (int m = 0; m < 4; ++m) _Pragma("unroll") for (int n = 0; n < 2; ++n) _Pragma("unroll") for (int k = 0; k < 2; ++k) \
      acc[ai][bj][m][n] = SWAP ? MMA1(Bt[n][k], At[m][k], acc[ai][bj][m][n]) : MMA1(At[m][k], Bt[n][k], acc[ai][bj][m][n]); \
    __builtin_amdgcn_s_setprio(0); } while (0)
#define WAIT_V(n) asm volatile("s_waitcnt vmcnt(" #n ")" ::: "memory")
#define WAIT_L(n) asm volatile("s_waitcnt lgkmcnt(" #n ")" ::: "memory")
#define BAR __builtin_amdgcn_s_barrier()
#define SCHED __builtin_amdgcn_sched_barrier(0)
  const int T = tidx(wv);
  int wid = T >> 6, lane = T & 63, wr = wid >> 2, wc = wid & 3, fr = lane & 15, fq = lane >> 4;
  bf16x8 At[4][2], B0[2][2], B1[2][2];
  const int nt = io.nt;
  if constexpr (!PRE) {
    STAGE_B(T, SB(0, 0), 0, 0); STAGE_A(T, SA(0, 0), 0, 0);
    STAGE_B(T, SB(0, 1), 1, 0); STAGE_A(T, SA(0, 1), 1, 0);
  }
  if (wr == 1) BAR;
  WAIT_V(4); BAR;
  STAGE_B(T, SB(1, 0), 0, 1); STAGE_A(T, SA(1, 0), 0, 1); STAGE_B(T, SB(1, 1), 1, 1);
  WAIT_V(6); BAR;
  for (int t = 0; t < nt - 2; t += 2) {
    LDB(B0, 0, 0); SCHED; LDA(At, 0, 0); STAGE_A(T, SA(1, 1), 1, t + 1);
    WAIT_L(8); BAR; WAIT_L(0); MMA(0, 0, At, B0); BAR; SCHED;
    LDB(B1, 0, 1); STAGE_B(T, SB(0, 0), 0, t + 2);
    BAR; WAIT_L(0); MMA(0, 1, At, B1); BAR;
    LDA(At, 0, 1); STAGE_A(T, SA(0, 0), 0, t + 2);
    BAR; WAIT_L(0); MMA(1, 0, At, B0); BAR; SCHED;
    STAGE_B(T, SB(0, 1), 1, t + 2);
    WAIT_V(6); BAR; MMA(1, 1, At, B1); BAR;
    LDB(B0, 1, 0); SCHED; LDA(At, 1, 0); STAGE_A(T, SA(0, 1), 1, t + 2);
    WAIT_L(8); BAR; WAIT_L(0); MMA(0, 0, At, B0); BAR; SCHED;
    LDB(B1, 1, 1); STAGE_B(T, SB(1, 0), 0, t + 3);
    BAR; WAIT_L(0); MMA(0, 1, At, B1); BAR;
    LDA(At, 1, 1); STAGE_A(T, SA(1, 0), 0, t + 3);
    BAR; WAIT_L(0); MMA(1, 0, At, B0); BAR; SCHED;
    STAGE_B(T, SB(1, 1), 1, t + 3);
    WAIT_V(6); BAR; MMA(1, 1, At, B1); BAR;
  }
  int tz = tidx(wv); asm volatile("" : "+v"(tz)); wid = tz >> 6; lane = tz & 63; wr = wid >> 2; wc = wid & 3; fr = lane & 15; fq = lane >> 4;
  { LDB(B0, 0, 0); WAIT_V(0); LDA(At, 0, 0); STAGE_A(tz, SA(1, 1), 1, nt - 1);
    BAR; WAIT_L(0); MMA(0, 0, At, B0); BAR;
    LDB(B1, 0, 1); BAR; WAIT_L(0); MMA(0, 1, At, B1); BAR;
    LDA(At, 0, 1); WAIT_V(4); BAR; WAIT_L(0); MMA(1, 0, At, B0); MMA(1, 1, At, B1); BAR; }
  { LDB(B0, 1, 0); LDA(At, 1, 0); WAIT_V(2); BAR; WAIT_L(0); MMA(0, 0, At, B0); BAR;
    LDB(B1, 1, 1); WAIT_V(0); BAR; WAIT_L(0); MMA(0, 1, At, B1); BAR;
    LDA(At, 1, 1); BAR; WAIT_L(0); MMA(1, 0, At, B0); MMA(1, 1, At, B1); BAR; }
  if (wr == 0) BAR;
}
template <bool GATHER, int KTPER>
__device__ __forceinline__ void gemm_issue0(const GemmIO& io, char* shmc, int wv) {
  bf16* shm = (bf16*)shmc;
  const int T = tidx(wv);
  STAGE_B(T, SB(0, 0), 0, 0); STAGE_A(T, SA(0, 0), 0, 0);
  STAGE_B(T, SB(0, 1), 1, 0); STAGE_A(T, SA(0, 1), 1, 0);
}
#undef SA
#undef SB


__device__ __forceinline__ void stage_coords(int T, int (&R)[2], int (&C)[2]) {
#pragma unroll
  for (int i = 0; i < 2; ++i) stage_rc(T * 16 + i * 8192, R[i], C[i]);
}

__device__ __forceinline__ void zero_acc(Acc& acc) {
#pragma unroll
  for (int a = 0; a < 2; ++a)
#pragma unroll
    for (int b = 0; b < 2; ++b)
#pragma unroll
      for (int m = 0; m < 4; ++m)
#pragma unroll
        for (int n = 0; n < 2; ++n) acc[a][b][m][n] = f32x4{0.f, 0.f, 0.f, 0.f};
}

__device__ __forceinline__ unsigned pack2(float a, float b) {
  unsigned r; asm volatile("v_cvt_pk_bf16_f32 %0, %1, %2" : "=v"(r) : "v"(a), "v"(b)); return r;
}


struct XRange { int start, size, per, off; };
__device__ __forceinline__ XRange xcd_range(int bid, int nb, int nwg) {
  XRange r; const int x = bid & 7, q = nwg >> 3, rem = nwg & 7;
  r.start = x * q + min(x, rem); r.size = q + (x < rem ? 1 : 0); r.per = nb >> 3; r.off = bid >> 3;
  return r;
}
template <int NN>
__device__ __forceinline__ void unit_from_L(int Lq, int nM, int& pm, int& pn) {
  const int g = Lq / (8 * NN), w = Lq - g * 8 * NN;
  const int gsz = nM - g * 8;
  if (gsz >= 8) { pm = g * 8 + (w & 7); pn = w >> 3; }
  else { pn = w / gsz; pm = g * 8 + (w - pn * gsz); }
}

__device__ __forceinline__ float bflo(unsigned w) { return __uint_as_float(w << 16); }
__device__ __forceinline__ float bfhi(unsigned w) { return __uint_as_float(w & 0xffff0000u); }
__device__ __forceinline__ float4 ld_xb4(const bf16* q) { const uint2 u = *(const uint2*)q; return make_float4(bflo(u.x), bfhi(u.x), bflo(u.y), bfhi(u.y)); }
__device__ __forceinline__ void st_xb4(bf16* q, float4 v) { uint2 o; o.x = pack2(v.x, v.y); o.y = pack2(v.z, v.w); *(uint2*)q = o; }

enum { F_HYIN, F_HYOUT, F_MDOWN, F_QUP, F_KVUP, F_WO, F_SHUP, F_SHDOWN };

template <int MODE>
__device__ __forceinline__ void fgemm_phase(const P& p, char* shm, int bid, int nb, int wv) {
  int N, K, lda, ldb; const bf16* A; const bf16* B;
  if constexpr (MODE == F_HYIN) { A = (const bf16*)p.w.h8; lda = 512; K = 512; N = 3072; B = (const bf16*)(p.w.W_hyin8 + (size_t)p.j * 3072 * 1024); ldb = 512; }
  if constexpr (MODE == F_HYOUT) { A = (const bf16*)p.w.yg8; lda = 512; K = 512; N = 1024; B = (const bf16*)(p.w.W_hyout8 + (size_t)p.j * 1024 * 1024); ldb = 512; }
  if constexpr (MODE == F_MDOWN) { A = (const bf16*)p.w.h8; lda = 512; K = 512; N = 768; B = (const bf16*)(p.w.W_mdown8 + (size_t)p.j * 768 * 1024); ldb = 512; }
  if constexpr (MODE == F_QUP) { A = p.w.lat; lda = 768; K = 384; N = 2048; B = p.w.W_qup + (size_t)p.j * 2048 * 384; ldb = 384; }
  if constexpr (MODE == F_KVUP) { A = p.w.lat + 384; lda = 768; K = 256; N = 2048; B = p.w.W_kvup + (size_t)p.j * 2048 * 256; ldb = 256; }
  if constexpr (MODE == F_WO) { A = p.w.o; lda = 1024; K = 1024; N = 1024; B = p.w.W_wo + (size_t)p.j * 1024 * 1024; ldb = 1024; }
  const int nN = N / 256, nM = p.nrows / 256, nunits = nM * nN;
  constexpr int NNC = MODE == F_HYIN ? 12 : (MODE == F_MDOWN ? 3 : (MODE == F_QUP || MODE == F_KVUP ? 8 : 4));
  constexpr bool SPLIT = (MODE == F_HYOUT || MODE == F_WO);
  const XRange xr = xcd_range(bid, nb, nunits);
  const int Fr = xr.size / xr.per, Rr = xr.size - Fr * xr.per;
  const bool split = SPLIT && Rr > 0 && 2 * Rr <= xr.per;
  auto body = [&](int pm, int pn, int half, auto halfTag) {
    constexpr bool HALF = decltype(halfTag)::value;
    const int brow = pm * 256, bcol = pn * 256 + half * 128;
    GemmIO io;
    io.A = A; io.B0 = B; io.B1 = B; io.B2 = B; io.nt = K / 64; io.ktper = io.nt;
    {
      int tz = tidx(wv); asm volatile("" : "+v"(tz));
      int R0, C0; stage_rc(tz * 16, R0, C0);
      io.a4[0] = (unsigned)((brow + R0) * lda + C0); io.a_h = 128 * lda; io.a_i = 64 * lda;
      io.b0 = (unsigned)((bcol + R0) * ldb + C0); io.b_h = HALF ? 0 : 128 * ldb;
      io.b_i = 64 * ldb;
    }
    Acc acc;
    zero_acc(acc);
    __syncthreads();
    gemm_core<MODE != F_HYIN, false, 0, HALF, false, (MODE == F_HYIN || MODE == F_MDOWN || MODE == F_HYOUT)>(io, shm, acc, wv);
    int T = tidx(wv); asm volatile("" : "+v"(T));
    const int wid = T >> 6, lane = T & 63, wr = wid >> 2, wc = wid & 3, fr = lane & 15, fq = lane >> 4;
    if constexpr (MODE == F_HYIN) {
      float4 sar[2][4];
#pragma unroll
      for (int ai = 0; ai < 2; ++ai)
#pragma unroll
        for (int m = 0; m < 4; ++m) sar[ai][m] = *(const float4*)(p.w.sa8 + brow + ai * 128 + wr * 64 + m * 16 + fq * 4);
#pragma unroll
      for (int bj = 0; bj < 2; ++bj)
#pragma unroll
        for (int n = 0; n < 2; ++n) {
          const int col = bcol + bj * 128 + wc * 32 + n * 16 + fr;
          const float bb = p.hy_in_b[p.j * 3072 + col];
          const float sw = p.w.s_hyin[p.j * 3072 + col];
#pragma unroll
          for (int ai = 0; ai < 2; ++ai)
#pragma unroll
            for (int m = 0; m < 4; ++m) {
              const int row = brow + ai * 128 + wr * 64 + m * 16 + fq * 4;
              const i32x4 vi = __builtin_bit_cast(i32x4, acc[ai][bj][m][n]);
              const float4 sa = sar[ai][m];
              uint2 o; o.x = pack2((float)vi[0] * sa.x * sw + bb, (float)vi[1] * sa.y * sw + bb); o.y = pack2((float)vi[2] * sa.z * sw + bb, (float)vi[3] * sa.w * sw + bb);
              if (!p.slot || o.x == 0x12345678u) *(uint2*)(p.w.zT + (size_t)col * NALL + row) = o;
            }
        }
    } else if constexpr (MODE == F_MDOWN) {
      float* red = (float*)shm;
      {
        float4 swc[2][2];
#pragma unroll
        for (int bj = 0; bj < 2; ++bj)
#pragma unroll
          for (int n = 0; n < 2; ++n) swc[bj][n] = *(const float4*)(p.w.s_mdown + p.j * 768 + bcol + bj * 128 + wc * 32 + n * 16 + fq * 4);
#pragma unroll
        for (int ai = 0; ai < 2; ++ai)
#pragma unroll
          for (int m = 0; m < 4; ++m) {
            const float sa = p.w.sa8[brow + ai * 128 + wr * 64 + m * 16 + fr];
#pragma unroll
            for (int bj = 0; bj < 2; ++bj)
#pragma unroll
              for (int n = 0; n < 2; ++n) {
                const i32x4 vi = __builtin_bit_cast(i32x4, acc[ai][bj][m][n]);
                acc[ai][bj][m][n] = f32x4{(float)vi[0] * sa * swc[bj][n].x, (float)vi[1] * sa * swc[bj][n].y, (float)vi[2] * sa * swc[bj][n].z, (float)vi[3] * sa * swc[bj][n].w};
              }
          }
      }
#pragma unroll
      for (int ai = 0; ai < 2; ++ai)
#pragma unroll
        for (int m = 0; m < 4; ++m) {
          const int rl = ai * 128 + wr * 64 + m * 16 + fr;
#pragma unroll
          for (int bj = 0; bj < 2; ++bj) {
            float sq = 0.f;
#pragma unroll
            for (int n = 0; n < 2; ++n) {
              const f32x4 v = acc[ai][bj][m][n];
              sq += v[0] * v[0] + v[1] * v[1] + v[2] * v[2] + v[3] * v[3];
              uint2 o; o.x = pack2(v[0], v[1]); o.y = pack2(v[2], v[3]);
              *(uint2*)(p.w.lat + (size_t)(brow + rl) * 768 + bcol + bj * 128 + wc * 32 + n * 16 + fq * 4) = o;
            }
            sq += swz_xor<16>(sq);
            { auto rr = __builtin_amdgcn_permlane32_swap(__float_as_uint(sq), __float_as_uint(sq), false, false); sq = __uint_as_float(rr[0]) + __uint_as_float(rr[1]); }
            if (fq == 0) red[(bj * 256 + rl) * 4 + wc] = sq;
          }
        }
      __syncthreads();
      if (T < 256) {
        const float4 a0 = *(const float4*)(red + T * 4), a1 = *(const float4*)(red + (256 + T) * 4);
        const float s0 = (a0.x + a0.y) + (a0.z + a0.w), s1 = (a1.x + a1.y) + (a1.z + a1.w);
        float* sq_q = p.w.ssq + brow + T; float* sq_kv = p.w.ssq + NALL + brow + T;
        if (pn == 0) atomicAdd(sq_q, s0 + s1);
        else if (pn == 1) { atomicAdd(sq_q, s0); atomicAdd(sq_kv, s1); }
        else atomicAdd(sq_kv, s0);
      }
    } else if constexpr (MODE == F_QUP) {
      float* red = (float*)shm;
      float rlat[2][4];
#pragma unroll
      for (int ai = 0; ai < 2; ++ai)
#pragma unroll
        for (int m = 0; m < 4; ++m) {
          const int rl = ai * 128 + wr * 64 + m * 16 + fr;
          rlat[ai][m] = rsqrtf(p.w.ssq[brow + rl] * (1.f / 384.f) + EPS);
          float sq = 0.f;
#pragma unroll
          for (int bj = 0; bj < 2; ++bj)
#pragma unroll
            for (int n = 0; n < 2; ++n) { const f32x4 v = acc[ai][bj][m][n]; sq += v[0] * v[0] + v[1] * v[1] + v[2] * v[2] + v[3] * v[3]; }
          sq += swz_xor<16>(sq);
          { auto rr = __builtin_amdgcn_permlane32_swap(__float_as_uint(sq), __float_as_uint(sq), false, false); sq = __uint_as_float(rr[0]) + __uint_as_float(rr[1]); }
          if (fq == 0) red[rl * 4 + wc] = sq;
        }
      __syncthreads();
      const float* gq = p.mla_q_head_g + p.j * 192;
#pragma unroll
      for (int ai = 0; ai < 2; ++ai)
#pragma unroll
        for (int m = 0; m < 4; ++m) {
          const int rl = ai * 128 + wr * 64 + m * 16 + fr;
          const int tok = brow + rl;
          const float4 a0 = *(const float4*)(red + rl * 4);
          const float tot = (a0.x + a0.y) + (a0.z + a0.w);
          const float rl2 = rlat[ai][m];
          const float scale = rl2 * rsqrtf(tot * rl2 * rl2 * (1.f / 192.f) + EPS);
          bf16* qd = p.w.q + (size_t)tok * 1536 + pn * 192;
#pragma unroll
          for (int bj = 0; bj < 2; ++bj) {
            if (bj == 1 && wc >= 2) continue;
            float val[2][4];
#pragma unroll
            for (int n = 0; n < 2; ++n) {
              const int col = bj * 128 + wc * 32 + n * 16 + fq * 4;
              const float4 gg = *(const float4*)(gq + col);
              const f32x4 v = acc[ai][bj][m][n];
              val[n][0] = v[0] * scale * gg.x; val[n][1] = v[1] * scale * gg.y; val[n][2] = v[2] * scale * gg.z; val[n][3] = v[3] * scale * gg.w;
            }
            if (bj == 1 && tok < NLAT) {
              const int t = tok & (SEQ - 1);
              const int pos = wc == 0 ? (t >> 6) : (t & 63);
              const float* cs = p.w.cs + (pos * 16 + fq * 4) * 2;
#pragma unroll
              for (int j = 0; j < 4; ++j) {
                const float c = cs[j * 2], sn = cs[j * 2 + 1];
                const float x1 = val[0][j], x2 = val[1][j];
                val[0][j] = x1 * c - x2 * sn; val[1][j] = x2 * c + x1 * sn;
              }
            }
#pragma unroll
            for (int n = 0; n < 2; ++n) {
              uint2 o; o.x = pack2(val[n][0], val[n][1]); o.y = pack2(val[n][2], val[n][3]);
              *(uint2*)(qd + bj * 128 + wc * 32 + n * 16 + fq * 4) = o;
            }
          }
        }
    } else if constexpr (MODE == F_KVUP) {
      float* red = (float*)shm;
      float* rk = red + 1024;
      float rkv[2][4];
#pragma unroll
      for (int ai = 0; ai < 2; ++ai)
#pragma unroll
        for (int m = 0; m < 4; ++m) {
          const int rl = ai * 128 + wr * 64 + m * 16 + fr;
          rkv[ai][m] = rsqrtf(p.w.ssq[NALL + brow + rl] * (1.f / 256.f) + EPS);
          float sq = 0.f;
#pragma unroll
          for (int n = 0; n < 2; ++n) { const f32x4 v = acc[ai][0][m][n]; sq += v[0] * v[0] + v[1] * v[1] + v[2] * v[2] + v[3] * v[3]; }
          sq += swz_xor<16>(sq);
          { auto rr = __builtin_amdgcn_permlane32_swap(__float_as_uint(sq), __float_as_uint(sq), false, false); sq = __uint_as_float(rr[0]) + __uint_as_float(rr[1]); }
          if (fq == 0) red[rl * 4 + wc] = sq;
          bf16* vd = p.w.v + (size_t)(brow + rl) * 1024 + pn * 128;
#pragma unroll
          for (int n = 0; n < 2; ++n) {
            const f32x4 v = acc[ai][1][m][n]; const float sc = rkv[ai][m];
            uint2 o; o.x = pack2(v[0] * sc, v[1] * sc); o.y = pack2(v[2] * sc, v[3] * sc);
            *(uint2*)(vd + wc * 32 + n * 16 + fq * 4) = o;
          }
        }
      __syncthreads();
      const float* gk = p.mla_k_head_g + p.j * 192;
      if (T < 256) {
        const int tok = brow + T;
        const float4 a0 = *(const float4*)(red + T * 4);
        const float rkvT = rsqrtf(p.w.ssq[NALL + tok] * (1.f / 256.f) + EPS);
        float tot = ((a0.x + a0.y) + (a0.z + a0.w)) * rkvT * rkvT;
        const uint4* src = (const uint4*)(p.w.lat + (size_t)tok * 768 + 640);
#pragma unroll
        for (int q = 0; q < 8; ++q) {
          const uint4 u = src[q];
          tot += bflo(u.x) * bflo(u.x) + bfhi(u.x) * bfhi(u.x) + bflo(u.y) * bflo(u.y) + bfhi(u.y) * bfhi(u.y);
          tot += bflo(u.z) * bflo(u.z) + bfhi(u.z) * bfhi(u.z) + bflo(u.w) * bflo(u.w) + bfhi(u.w) * bfhi(u.w);
        }
        const float rks = rsqrtf(tot * (1.f / 192.f) + EPS);
        rk[T] = rks;
        const int t = tok & (SEQ - 1);
#pragma unroll
        for (int ax = 0; ax < 2; ++ax) {
          float pe[32];
#pragma unroll
          for (int q = 0; q < 4; ++q) {
            const uint4 u = src[ax * 4 + q];
            pe[q * 8 + 0] = bflo(u.x); pe[q * 8 + 1] = bfhi(u.x); pe[q * 8 + 2] = bflo(u.y); pe[q * 8 + 3] = bfhi(u.y);
            pe[q * 8 + 4] = bflo(u.z); pe[q * 8 + 5] = bfhi(u.z); pe[q * 8 + 6] = bflo(u.w); pe[q * 8 + 7] = bfhi(u.w);
          }
#pragma unroll
          for (int q = 0; q < 32; ++q) pe[q] *= rks * gk[128 + ax * 32 + q];
          if (tok < NLAT) {
            const int pos = ax == 0 ? (t >> 6) : (t & 63);
            const float* cs = p.w.cs + pos * 32;
#pragma unroll
            for (int i = 0; i < 16; ++i) {
              const float c = cs[i * 2], sn = cs[i * 2 + 1];
              const float x1 = pe[i], x2 = pe[16 + i];
              pe[i] = x1 * c - x2 * sn; pe[16 + i] = x2 * c + x1 * sn;
            }
          }
          uint4* dst = (uint4*)(p.w.k + (size_t)tok * 1536 + pn * 192 + 128 + ax * 32);
#pragma unroll
          for (int q = 0; q < 4; ++q) {
            uint4 o;
            o.x = pack2(pe[q * 8], pe[q * 8 + 1]); o.y = pack2(pe[q * 8 + 2], pe[q * 8 + 3]); o.z = pack2(pe[q * 8 + 4], pe[q * 8 + 5]); o.w = pack2(pe[q * 8 + 6], pe[q * 8 + 7]);
            dst[q] = o;
          }
        }
      }
      __syncthreads();
#pragma unroll
      for (int ai = 0; ai < 2; ++ai)
#pragma unroll
        for (int m = 0; m < 4; ++m) {
          const int rl = ai * 128 + wr * 64 + m * 16 + fr;
          const float sc = rkv[ai][m] * rk[rl];
          bf16* kd = p.w.k + (size_t)(brow + rl) * 1536 + pn * 192;
#pragma unroll
          for (int n = 0; n < 2; ++n) {
            const int col = wc * 32 + n * 16 + fq * 4;
            const float4 gg = *(const float4*)(gk + col);
            const f32x4 v = acc[ai][0][m][n];
            uint2 o; o.x = pack2(v[0] * sc * gg.x, v[1] * sc * gg.y); o.y = pack2(v[2] * sc * gg.z, v[3] * sc * gg.w);
            *(uint2*)(kd + col) = o;
          }
        }
    } else
#pragma unroll
    for (int ai = 0; ai < 2; ++ai)
#pragma unroll
      for (int m = 0; m < 4; ++m) {
        const int row = brow + ai * 128 + wr * 64 + m * 16 + fr;
        {
#pragma unroll
          for (int bj = 0; bj < (HALF ? 1 : 2); ++bj)
#pragma unroll
            for (int n = 0; n < 2; ++n) {
              f32x4 v = acc[ai][bj][m][n];
              const int col = bcol + bj * 128 + wc * 32 + n * 16 + fq * 4;
              if constexpr (MODE == F_HYOUT) {
                const i32x4 vi = __builtin_bit_cast(i32x4, v);
                const float sa = p.w.syg[row];
                const float4 sw = *(const float4*)(p.w.s_hyout + p.j * 1024 + col);
                v = f32x4{(float)vi[0] * sa * sw.x, (float)vi[1] * sa * sw.y, (float)vi[2] * sa * sw.z, (float)vi[3] * sa * sw.w};
              }
              if constexpr (MODE == F_HYOUT || MODE == F_WO) {
                const float* mod = modrow(p, row) + 2 * 1024 + col;
                const float4 gg = *(const float4*)mod;
                float4 bb = make_float4(0, 0, 0, 0);
                if constexpr (MODE == F_HYOUT) bb = *(const float4*)(p.hy_out_b + p.j * 1024 + col);
                bf16* xp = (p.slot ? (MODE == F_HYOUT ? (bf16*)((char*)p.w.zT + ((size_t)76 << 20)) : p.w.q) : p.w.xb) + (size_t)row * 1024 + col;
                float4 xv;
                if (p.layer == 0) xv = *(const float4*)((row < NLAT ? p.x + (size_t)row * 1024 : p.ctx + (size_t)(row - NLAT) * 1024) + col);
                else xv = ld_xb4(xp);
                xv.x += (v[0] + bb.x) * gg.x; xv.y += (v[1] + bb.y) * gg.y; xv.z += (v[2] + bb.z) * gg.z; xv.w += (v[3] + bb.w) * gg.w;
                st_xb4(xp, xv);
              }
            }
        }
      }
  };
  for (int i = 0; i * xr.per < xr.size; ++i) {
    int pm, pn;
    if constexpr (SPLIT) {
      if (split && i == Fr) {
        if (xr.off >= 2 * Rr) continue;
        unit_from_L<NNC>(xr.start + Fr * xr.per + (xr.off >> 1), nM, pm, pn);
        body(pm, pn, xr.off & 1, std::true_type{});
        continue;
      }
    }
    const int loc = i * xr.per + xr.off;
    if (loc >= xr.size) continue;
    unit_from_L<NNC>(xr.start + loc, nM, pm, pn);
    body(pm, pn, 0, std::false_type{});
  }
}


__device__ __forceinline__ void mla_up_phase(const P& p, char* shm, int bid, int nb, int wv, bool q_ctx) {
  const int nMq = (q_ctx ? NALL : NLAT) / 256, nMk = NALL / 256;
  const int nQ = nMq * 8, nunits = nQ + nMk * 8;
  const XRange xr = xcd_range(bid, nb, nunits);
  auto setup = [&](int r, int& isq, int& pm, int& pn, GemmIO& io) -> bool {
    const int loc = r * xr.per + xr.off;
    if (loc >= xr.size) return false;
    const int Lq = xr.start + loc;
    isq = Lq < nQ ? 1 : 0;
    unit_from_L<8>(isq ? Lq : Lq - nQ, isq ? nMq : nMk, pm, pn);
    const int K = isq ? 384 : 256;
    const bf16* B = isq ? p.w.W_qup + (size_t)p.j * 2048 * 384 : p.w.W_kvup + (size_t)p.j * 2048 * 256;
    io.A = isq ? p.w.lat : p.w.lat + 384; io.B0 = B; io.B1 = B; io.B2 = B; io.nt = K / 64; io.ktper = io.nt;
    int tz = tidx(wv);
    int R0, C0; stage_rc(tz * 16, R0, C0);
    io.a4[0] = (unsigned)((pm * 256 + R0) * 768 + C0); io.a_h = 128 * 768; io.a_i = 64 * 768;
    io.b0 = (unsigned)((pn * 256 + R0) * K + C0); io.b_h = 128 * K; io.b_i = 64 * K;
    return true;
  };
  int isq, pm, pn; GemmIO io;
  bool have = setup(0, isq, pm, pn, io);
  __syncthreads();
  if (have) gemm_issue0<false, 0>(io, shm, wv);
  for (int r = 0; have; ++r) {
    const int brow = pm * 256;
    const int cisq = isq, cpn = pn;
    Acc acc;
    zero_acc(acc);
    gemm_core<true, false, 0, false, true>(io, shm, acc, wv);
    have = setup(r + 1, isq, pm, pn, io);
    if (have) gemm_issue0<false, 0>(io, shm, wv);
    int T = tidx(wv); asm volatile("" : "+v"(T));
    const int wid = T >> 6, lane = T & 63, wr = wid >> 2, wc = wid & 3, fr = lane & 15, fq = lane >> 4;
    if (cisq) {
      const int pn = cpn;
      float* red = (float*)(shm + 32768);
      float rlat[2][4];
#pragma unroll
      for (int ai = 0; ai < 2; ++ai)
#pragma unroll
        for (int m = 0; m < 4; ++m) {
          const int rl = ai * 128 + wr * 64 + m * 16 + fr;
          rlat[ai][m] = rsqrtf(p.w.ssq[brow + rl] * (1.f / 384.f) + EPS);
          float sq = 0.f;
#pragma unroll
          for (int bj = 0; bj < 2; ++bj)
#pragma unroll
            for (int n = 0; n < 2; ++n) { const f32x4 v = acc[ai][bj][m][n]; sq += v[0] * v[0] + v[1] * v[1] + v[2] * v[2] + v[3] * v[3]; }
          sq += swz_xor<16>(sq);
          { auto rr = __builtin_amdgcn_permlane32_swap(__float_as_uint(sq), __float_as_uint(sq), false, false); sq = __uint_as_float(rr[0]) + __uint_as_float(rr[1]); }
          if (fq == 0) red[rl * 4 + wc] = sq;
        }
      __syncthreads();
      const float* gq = p.mla_q_head_g + p.j * 192;
#pragma unroll
      for (int ai = 0; ai < 2; ++ai)
#pragma unroll
        for (int m = 0; m < 4; ++m) {
          const int rl = ai * 128 + wr * 64 + m * 16 + fr;
          const int tok = brow + rl;
          const float4 a0 = *(const float4*)(red + rl * 4);
          const float tot = (a0.x + a0.y) + (a0.z + a0.w);
          const float rl2 = rlat[ai][m];
          const float scale = rl2 * rsqrtf(tot * rl2 * rl2 * (1.f / 192.f) + EPS);
          bf16* qd = p.w.q + (size_t)tok * 1536 + pn * 192;
#pragma unroll
          for (int bj = 0; bj < 2; ++bj) {
            if (bj == 1 && wc >= 2) continue;
            float val[2][4];
#pragma unroll
            for (int n = 0; n < 2; ++n) {
              const int col = bj * 128 + wc * 32 + n * 16 + fq * 4;
              const float4 gg = *(const float4*)(gq + col);
              const f32x4 v = acc[ai][bj][m][n];
              val[n][0] = v[0] * scale * gg.x; val[n][1] = v[1] * scale * gg.y; val[n][2] = v[2] * scale * gg.z; val[n][3] = v[3] * scale * gg.w;
            }
            if (bj == 1 && tok < NLAT) {
              const int t = tok & (SEQ - 1);
              const int pos = wc == 0 ? (t >> 6) : (t & 63);
              const float* cs = p.w.cs + (pos * 16 + fq * 4) * 2;
#pragma unroll
              for (int j = 0; j < 4; ++j) {
                const float c = cs[j * 2], sn = cs[j * 2 + 1];
                const float x1 = val[0][j], x2 = val[1][j];
                val[0][j] = x1 * c - x2 * sn; val[1][j] = x2 * c + x1 * sn;
              }
            }
#pragma unroll
            for (int n = 0; n < 2; ++n) {
              uint2 o; o.x = pack2(val[n][0], val[n][1]); o.y = pack2(val[n][2], val[n][3]);
              *(uint2*)(qd + bj * 128 + wc * 32 + n * 16 + fq * 4) = o;
            }
          }
        }
    } else {
      const int pn = cpn;
      float* red = (float*)(shm + 32768);
      float* rk = red + 1024;
      float rkv[2][4];
#pragma unroll
      for (int ai = 0; ai < 2; ++ai)
#pragma unroll
        for (int m = 0; m < 4; ++m) {
          const int rl = ai * 128 + wr * 64 + m * 16 + fr;
          rkv[ai][m] = rsqrtf(p.w.ssq[NALL + brow + rl] * (1.f / 256.f) + EPS);
          float sq = 0.f;
#pragma unroll
          for (int n = 0; n < 2; ++n) { const f32x4 v = acc[ai][0][m][n]; sq += v[0] * v[0] + v[1] * v[1] + v[2] * v[2] + v[3] * v[3]; }
          sq += swz_xor<16>(sq);
          { auto rr = __builtin_amdgcn_permlane32_swap(__float_as_uint(sq), __float_as_uint(sq), false, false); sq = __uint_as_float(rr[0]) + __uint_as_float(rr[1]); }
          if (fq == 0) red[rl * 4 + wc] = sq;
          bf16* vd = p.w.v + (size_t)(brow + rl) * 1024 + pn * 128;
#pragma unroll
          for (int n = 0; n < 2; ++n) {
            const f32x4 v = acc[ai][1][m][n]; const float sc = rkv[ai][m];
            uint2 o; o.x = pack2(v[0] * sc, v[1] * sc); o.y = pack2(v[2] * sc, v[3] * sc);
            *(uint2*)(vd + wc * 32 + n * 16 + fq * 4) = o;
          }
        }
      __syncthreads();
      const float* gk = p.mla_k_head_g + p.j * 192;
      if (T < 256) {
        const int tok = brow + T;
        const float4 a0 = *(const float4*)(red + T * 4);
        const float rkvT = rsqrtf(p.w.ssq[NALL + tok] * (1.f / 256.f) + EPS);
        float tot = ((a0.x + a0.y) + (a0.z + a0.w)) * rkvT * rkvT;
        const uint4* src = (const uint4*)(p.w.lat + (size_t)tok * 768 + 640);
#pragma unroll
        for (int q = 0; q < 8; ++q) {
          const uint4 u = src[q];
          tot += bflo(u.x) * bflo(u.x) + bfhi(u.x) * bfhi(u.x) + bflo(u.y) * bflo(u.y) + bfhi(u.y) * bfhi(u.y);
          tot += bflo(u.z) * bflo(u.z) + bfhi(u.z) * bfhi(u.z) + bflo(u.w) * bflo(u.w) + bfhi(u.w) * bfhi(u.w);
        }
        const float rks = rsqrtf(tot * (1.f / 192.f) + EPS);
        rk[T] = rks;
        const int t = tok & (SEQ - 1);
#pragma unroll
        for (int ax = 0; ax < 2; ++ax) {
          float pe[32];
#pragma unroll
          for (int q = 0; q < 4; ++q) {
            const uint4 u = src[ax * 4 + q];
            pe[q * 8 + 0] = bflo(u.x); pe[q * 8 + 1] = bfhi(u.x); pe[q * 8 + 2] = bflo(u.y); pe[q * 8 + 3] = bfhi(u.y);
            pe[q * 8 + 4] = bflo(u.z); pe[q * 8 + 5] = bfhi(u.z); pe[q * 8 + 6] = bflo(u.w); pe[q * 8 + 7] = bfhi(u.w);
          }
#pragma unroll
          for (int q = 0; q < 32; ++q) pe[q] *= rks * gk[128 + ax * 32 + q];
          if (tok < NLAT) {
            const int pos = ax == 0 ? (t >> 6) : (t & 63);
            const float* cs = p.w.cs + pos * 32;
#pragma unroll
            for (int i = 0; i < 16; ++i) {
              const float c = cs[i * 2], sn = cs[i * 2 + 1];
              const float x1 = pe[i], x2 = pe[16 + i];
              pe[i] = x1 * c - x2 * sn; pe[16 + i] = x2 * c + x1 * sn;
            }
          }
          uint4* dst = (uint4*)(p.w.k + (size_t)tok * 1536 + pn * 192 + 128 + ax * 32);
#pragma unroll
          for (int q = 0; q < 4; ++q) {
            uint4 o;
            o.x = pack2(pe[q * 8], pe[q * 8 + 1]); o.y = pack2(pe[q * 8 + 2], pe[q * 8 + 3]); o.z = pack2(pe[q * 8 + 4], pe[q * 8 + 5]); o.w = pack2(pe[q * 8 + 6], pe[q * 8 + 7]);
            dst[q] = o;
          }
        }
      }
      __syncthreads();
#pragma unroll
      for (int ai = 0; ai < 2; ++ai)
#pragma unroll
        for (int m = 0; m < 4; ++m) {
          const int rl = ai * 128 + wr * 64 + m * 16 + fr;
          const float sc = rkv[ai][m] * rk[rl];
          bf16* kd = p.w.k + (size_t)(brow + rl) * 1536 + pn * 192;
#pragma unroll
          for (int n = 0; n < 2; ++n) {
            const int col = wc * 32 + n * 16 + fq * 4;
            const float4 gg = *(const float4*)(gk + col);
            const f32x4 v = acc[ai][0][m][n];
            uint2 o; o.x = pack2(v[0] * sc * gg.x, v[1] * sc * gg.y); o.y = pack2(v[2] * sc * gg.z, v[3] * sc * gg.w);
            *(uint2*)(kd + col) = o;
          }
        }
    }
  }
}

struct SUnit {
  const char* A; const char* B0; const char* B1; const char* B2;
  unsigned a_h, b_h;
  unsigned va[4];
  unsigned vb[2];
  int nt;
  int t0, t1, t2, t3;
};
template <class F>
__device__ __forceinline__ void gemm_stream(F& f, char* lds, int wv) {
  constexpr bool GATHER = F::GATHER; constexpr int KTPER = F::KTPER;
  int T = tidx(wv);
  const int wid = T >> 6, lane = T & 63, wr = wid >> 2, wc = wid & 3, fr = lane & 15, fq = lane >> 4;
  const int aoff = lds_byte(wr * 64 + fr, fq * 8), boff = lds_byte(wc * 32 + fr, fq * 8);
#define GS_SA(b, h) (((b) * 2 + (h)) * 16384)
#define GS_SB(b, h) ((4 + (b) * 2 + (h)) * 16384)
#define GS_STG(bufoff, gbase, v0, v1) do { GLDS((gbase) + (v0), lds + (bufoff) + T * 16); GLDS((gbase) + (v1), lds + (bufoff) + T * 16 + 8192); } while (0)
#define GS_LDA(dst, b, h) do { _Pragma("unroll") for (int m = 0; m < 4; ++m) _Pragma("unroll") for (int k = 0; k < 2; ++k) dst[m][k] = *(const bf16x8*)(lds + GS_SA(b, h) + aoff + m * 2048 + k * 1024); } while (0)
#define GS_LDB(dst, b, h) do { _Pragma("unroll") for (int n = 0; n < 2; ++n) _Pragma("unroll") for (int k = 0; k < 2; ++k) dst[n][k] = *(const bf16x8*)(lds + GS_SB(b, h) + boff + n * 2048 + k * 1024); } while (0)
#define GS_MMA(ai, bj, At, Bt) do { __builtin_amdgcn_s_setprio(1); _Pragma("unroll") for (int m = 0; m < 4; ++m) _Pragma("unroll") for (int n = 0; n < 2; ++n) _Pragma("unroll") for (int k = 0; k < 2; ++k) \
    acc[ai][bj][m][n] = F::SWAP ? __builtin_amdgcn_mfma_f32_16x16x32_bf16(Bt[n][k], At[m][k], acc[ai][bj][m][n], 0, 0, 0) : __builtin_amdgcn_mfma_f32_16x16x32_bf16(At[m][k], Bt[n][k], acc[ai][bj][m][n], 0, 0, 0); __builtin_amdgcn_s_setprio(0); } while (0)
#define GS_COPY(d, s_) do { (d).A = (s_).A; (d).B0 = (s_).B0; (d).B1 = (s_).B1; (d).B2 = (s_).B2; (d).a_h = (s_).a_h; (d).b_h = (s_).b_h; (d).vb[0] = (s_).vb[0]; (d).vb[1] = (s_).vb[1]; \
    (d).nt = (s_).nt; (d).t0 = (s_).t0; (d).t1 = (s_).t1; (d).t2 = (s_).t2; (d).t3 = (s_).t3; if (GATHER) { (d).va[0] = (s_).va[0]; (d).va[1] = (s_).va[1]; (d).va[2] = (s_).va[2]; (d).va[3] = (s_).va[3]; } } while (0)
#define GS_VA(u, h, i) (GATHER ? (u).va[(h) * 2 + (i)] : ((i) ? f.fa1 : f.fa0))
#define GS_BSEG(u, kt) (KTPER ? (((kt) < KTPER ? (u).B0 : ((kt) < 2 * KTPER ? (u).B1 : (u).B2)) + (size_t)((kt) % (KTPER ? KTPER : 1)) * 128) : (u).B0 + (size_t)(kt) * 128)
  SUnit cur, nxt;
  if (!f.get(0, cur)) return;
  Acc acc;
  zero_acc(acc);
  bf16x8 At[4][2], B0[2][2], B1[2][2];
  __syncthreads();
  {
    const char* b0 = GS_BSEG(cur, 0); const char* b1 = GS_BSEG(cur, 1);
    GS_STG(GS_SB(0, 0), b0, cur.vb[0], cur.vb[1]); GS_STG(GS_SA(0, 0), cur.A, GS_VA(cur, 0, 0), GS_VA(cur, 0, 1));
    GS_STG(GS_SB(0, 1), b0 + cur.b_h, cur.vb[0], cur.vb[1]); GS_STG(GS_SA(0, 1), cur.A + (GATHER ? 0u : cur.a_h), GS_VA(cur, 1, 0), GS_VA(cur, 1, 1));
    if (wr == 1) BAR;
    WAIT_V(4); BAR;
    GS_STG(GS_SB(1, 0), b1, cur.vb[0], cur.vb[1]); GS_STG(GS_SA(1, 0), cur.A + 128, GS_VA(cur, 0, 0), GS_VA(cur, 0, 1)); GS_STG(GS_SB(1, 1), b1 + cur.b_h, cur.vb[0], cur.vb[1]);
    WAIT_V(6); BAR;
  }
  for (int ui = 0;; ++ui) {
    const bool has_next = f.get(ui + 1, nxt);
    if (!has_next) GS_COPY(nxt, cur);
    const int nt = cur.nt;
    const bool nohalf = (cur.t3 & 1) == 0;
    for (int t = 0; t < nt; t += 2) {
      const bool last = (t == nt - 2);
      const char* a1 = cur.A + (GATHER ? 0u : cur.a_h) + (size_t)(t + 1) * 128;
      const char* a2 = last ? nxt.A : cur.A + (size_t)(t + 2) * 128;
      const unsigned ah2 = GATHER ? 0u : (last ? nxt.a_h : cur.a_h);
      const char* b2 = last ? GS_BSEG(nxt, 0) : GS_BSEG(cur, t + 2);
      const char* b3 = last ? GS_BSEG(nxt, 1) : GS_BSEG(cur, t + 3);
      const unsigned bh2 = last ? nxt.b_h : cur.b_h;
      unsigned va2[4], vb2[2];
#pragma unroll
      for (int q = 0; q < 4; ++q) va2[q] = GATHER ? (last ? nxt.va[q] : cur.va[q]) : (q & 1 ? f.fa1 : f.fa0);
#pragma unroll
      for (int q = 0; q < 2; ++q) vb2[q] = last ? nxt.vb[q] : cur.vb[q];
      GS_LDB(B0, 0, 0); SCHED; GS_LDA(At, 0, 0); GS_STG(GS_SA(1, 1), a1, GS_VA(cur, 1, 0), GS_VA(cur, 1, 1));
      WAIT_L(8); BAR; WAIT_L(0); GS_MMA(0, 0, At, B0); BAR; SCHED;
      GS_LDB(B1, 0, 1); GS_STG(GS_SB(0, 0), b2, vb2[0], vb2[1]);
      BAR; WAIT_L(0); if (nohalf) GS_MMA(0, 1, At, B1); BAR;
      GS_LDA(At, 0, 1); GS_STG(GS_SA(0, 0), a2, va2[0], va2[1]);
      BAR; WAIT_L(0); GS_MMA(1, 0, At, B0); BAR; SCHED;
      GS_STG(GS_SB(0, 1), b2 + bh2, vb2[0], vb2[1]);
      WAIT_V(6); BAR; if (nohalf) GS_MMA(1, 1, At, B1); BAR;
      GS_LDB(B0, 1, 0); SCHED; GS_LDA(At, 1, 0); GS_STG(GS_SA(0, 1), a2 + ah2, va2[2], va2[3]);
      WAIT_L(8); BAR; WAIT_L(0); GS_MMA(0, 0, At, B0); BAR; SCHED;
      GS_LDB(B1, 1, 1); GS_STG(GS_SB(1, 0), b3, vb2[0], vb2[1]);
      BAR; WAIT_L(0); if (nohalf) GS_MMA(0, 1, At, B1); BAR;
      GS_LDA(At, 1, 1); GS_STG(GS_SA(1, 0), a2 + 128, va2[0], va2[1]);
      BAR; WAIT_L(0); GS_MMA(1, 0, At, B0); BAR; SCHED;
      GS_STG(GS_SB(1, 1), b3 + bh2, vb2[0], vb2[1]);
      WAIT_V(6); BAR; if (nohalf) GS_MMA(1, 1, At, B1); BAR;
    }
    if constexpr (F::SYNC_EPI) { if (wr == 0) BAR; }
    f.epi(cur, acc, lds);
    if constexpr (F::SYNC_EPI) { BAR; if (wr == 1) BAR; }
    if (!has_next) break;
    zero_acc(acc);
    GS_COPY(cur, nxt);
    T = tidx(wv);
  }
  WAIT_V(0);
  if (wr == 0) BAR;
  BAR;
#undef GS_SA
#undef GS_SB
#undef GS_STG
#undef GS_LDA
#undef GS_LDB
#undef GS_MMA
#undef GS_BSEG
#undef GS_VA
#undef GS_COPY
}


struct FUp {
  static constexpr bool GATHER = false, SYNC_EPI = true, SWAP = true; static constexpr int KTPER = 0;
  const P& p; XRange xr; int nMq, nMk, nQ; int wv; unsigned fa0, fa1, vq0, vq1, vk0, vk1;
  __device__ __forceinline__ FUp(const P& p_, int bid, int nb, int wv_, bool q_ctx) : p(p_), wv(wv_) {
    nMq = (q_ctx ? NALL : NLAT) / 256; nMk = NALL / 256; nQ = nMq * 8;
    xr = xcd_range(bid, nb, nQ + nMk * 8);
    int R0, C0; stage_rc(tidx(wv) * 16, R0, C0);
    fa0 = (unsigned)(R0 * 768 + C0) * 2u; fa1 = fa0 + 64u * 768u * 2u;
    vq0 = (unsigned)(R0 * 384 + C0) * 2u; vq1 = vq0 + 64u * 384u * 2u;
    vk0 = (unsigned)(R0 * 256 + C0) * 2u; vk1 = vk0 + 64u * 256u * 2u;
  }
  __device__ __forceinline__ bool get(int i, SUnit& u) const {
    const int loc = i * xr.per + xr.off;
    if (loc >= xr.size) return false;
    const int Lq = xr.start + loc;
    const int isq = Lq < nQ ? 1 : 0;
    int pm, pn; unit_from_L<8>(isq ? Lq : Lq - nQ, isq ? nMq : nMk, pm, pn);
    const int K = isq ? 384 : 256;
    u.A = (const char*)(p.w.lat + (size_t)pm * 256 * 768 + (isq ? 0 : 384));
    u.B0 = (const char*)((isq ? p.w.W_qup + (size_t)p.j * 2048 * 384 : p.w.W_kvup + (size_t)p.j * 2048 * 256) + (size_t)pn * 256 * K); u.B1 = u.B0; u.B2 = u.B0;
    u.a_h = 128u * 768u * 2u; u.b_h = 128u * (unsigned)K * 2u;
    u.vb[0] = isq ? vq0 : vk0; u.vb[1] = isq ? vq1 : vk1;
    u.nt = K / 64; u.t0 = pm; u.t1 = pn; u.t2 = isq; u.t3 = 0;
    return true;
  }
  __device__ __forceinline__ void epi(const SUnit& u, Acc& acc, char* shm) const {
    int T = tidx(wv); asm volatile("" : "+v"(T));
    const int wid = T >> 6, lane = T & 63, wr = wid >> 2, wc = wid & 3, fr = lane & 15, fq = lane >> 4;
    const int brow = u.t0 * 256, pn = u.t1;
    if (u.t2) {
      float* red = (float*)(shm + 49152);
      float rlat[2][4];
#pragma unroll
      for (int ai = 0; ai < 2; ++ai)
#pragma unroll
        for (int m = 0; m < 4; ++m) {
          const int rl = ai * 128 + wr * 64 + m * 16 + fr;
          rlat[ai][m] = rsqrtf(p.w.ssq[brow + rl] * (1.f / 384.f) + EPS);
          float sq = 0.f;
#pragma unroll
          for (int bj = 0; bj < 2; ++bj)
#pragma unroll
            for (int n = 0; n < 2; ++n) { const f32x4 v = acc[ai][bj][m][n]; sq += v[0] * v[0] + v[1] * v[1] + v[2] * v[2] + v[3] * v[3]; }
          sq += swz_xor<16>(sq);
          { auto rr = __builtin_amdgcn_permlane32_swap(__float_as_uint(sq), __float_as_uint(sq), false, false); sq = __uint_as_float(rr[0]) + __uint_as_float(rr[1]); }
          if (fq == 0) red[rl * 4 + wc] = sq;
        }
      __syncthreads();
      const float* gq = p.mla_q_head_g + p.j * 192;
#pragma unroll
      for (int ai = 0; ai < 2; ++ai)
#pragma unroll
        for (int m = 0; m < 4; ++m) {
          const int rl = ai * 128 + wr * 64 + m * 16 + fr;
          const int tok = brow + rl;
          const float4 a0 = *(const float4*)(red + rl * 4);
          const float tot = (a0.x + a0.y) + (a0.z + a0.w);
          const float rl2 = rlat[ai][m];
          const float scale = rl2 * rsqrtf(tot * rl2 * rl2 * (1.f / 192.f) + EPS);
          bf16* qd = p.w.q + (size_t)tok * 1536 + pn * 192;
#pragma unroll
          for (int bj = 0; bj < 2; ++bj) {
            if (bj == 1 && wc >= 2) continue;
            float val[2][4];
#pragma unroll
            for (int n = 0; n < 2; ++n) {
              const int col = bj * 128 + wc * 32 + n * 16 + fq * 4;
              const float4 gg = *(const float4*)(gq + col);
              const f32x4 v = acc[ai][bj][m][n];
              val[n][0] = v[0] * scale * gg.x; val[n][1] = v[1] * scale * gg.y; val[n][2] = v[2] * scale * gg.z; val[n][3] = v[3] * scale * gg.w;
            }
            if (bj == 1 && tok < NLAT) {
              const int t = tok & (SEQ - 1);
              const int pos = wc == 0 ? (t >> 6) : (t & 63);
              const float* cs = p.w.cs + (pos * 16 + fq * 4) * 2;
#pragma unroll
              for (int j = 0; j < 4; ++j) {
                const float c = cs[j * 2], sn = cs[j * 2 + 1];
                const float x1 = val[0][j], x2 = val[1][j];
                val[0][j] = x1 * c - x2 * sn; val[1][j] = x2 * c + x1 * sn;
              }
            }
#pragma unroll
            for (int n = 0; n < 2; ++n) {
              uint2 o; o.x = pack2(val[n][0], val[n][1]); o.y = pack2(val[n][2], val[n][3]);
              *(uint2*)(qd + bj * 128 + wc * 32 + n * 16 + fq * 4) = o;
            }
          }
        }
    } else {
      float* red = (float*)(shm + 49152);
      float* rk = red + 1024;
      float rkv[2][4];
#pragma unroll
      for (int ai = 0; ai < 2; ++ai)
#pragma unroll
        for (int m = 0; m < 4; ++m) {
          const int rl = ai * 128 + wr * 64 + m * 16 + fr;
          rkv[ai][m] = rsqrtf(p.w.ssq[NALL + brow + rl] * (1.f / 256.f) + EPS);
          float sq = 0.f;
#pragma unroll
          for (int n = 0; n < 2; ++n) { const f32x4 v = acc[ai][0][m][n]; sq += v[0] * v[0] + v[1] * v[1] + v[2] * v[2] + v[3] * v[3]; }
          sq += swz_xor<16>(sq);
          { auto rr = __builtin_amdgcn_permlane32_swap(__float_as_uint(sq), __float_as_uint(sq), false, false); sq = __uint_as_float(rr[0]) + __uint_as_float(rr[1]); }
          if (fq == 0) red[rl * 4 + wc] = sq;
          bf16* vd = p.w.v + (size_t)(brow + rl) * 1024 + pn * 128;
#pragma unroll
          for (int n = 0; n < 2; ++n) {
            const f32x4 v = acc[ai][1][m][n]; const float sc = rkv[ai][m];
            uint2 o; o.x = pack2(v[0] * sc, v[1] * sc); o.y = pack2(v[2] * sc, v[3] * sc);
            *(uint2*)(vd + wc * 32 + n * 16 + fq * 4) = o;
          }
        }
      __syncthreads();
      const float* gk = p.mla_k_head_g + p.j * 192;
      if (T < 256) {
        const int tok = brow + T;
        const float4 a0 = *(const float4*)(red + T * 4);
        const float rkvT = rsqrtf(p.w.ssq[NALL + tok] * (1.f / 256.f) + EPS);
        float tot = ((a0.x + a0.y) + (a0.z + a0.w)) * rkvT * rkvT;
        const uint4* src = (const uint4*)(p.w.lat + (size_t)tok * 768 + 640);
#pragma unroll
        for (int q = 0; q < 8; ++q) {
          const uint4 u = src[q];
          tot += bflo(u.x) * bflo(u.x) + bfhi(u.x) * bfhi(u.x) + bflo(u.y) * bflo(u.y) + bfhi(u.y) * bfhi(u.y);
          tot += bflo(u.z) * bflo(u.z) + bfhi(u.z) * bfhi(u.z) + bflo(u.w) * bflo(u.w) + bfhi(u.w) * bfhi(u.w);
        }
        const float rks = rsqrtf(tot * (1.f / 192.f) + EPS);
        rk[T] = rks;
        const int t = tok & (SEQ - 1);
#pragma unroll
        for (int ax = 0; ax < 2; ++ax) {
          float pe[32];
#pragma unroll
          for (int q = 0; q < 4; ++q) {
            const uint4 u = src[ax * 4 + q];
            pe[q * 8 + 0] = bflo(u.x); pe[q * 8 + 1] = bfhi(u.x); pe[q * 8 + 2] = bflo(u.y); pe[q * 8 + 3] = bfhi(u.y);
            pe[q * 8 + 4] = bflo(u.z); pe[q * 8 + 5] = bfhi(u.z); pe[q * 8 + 6] = bflo(u.w); pe[q * 8 + 7] = bfhi(u.w);
          }
#pragma unroll
          for (int q = 0; q < 32; ++q) pe[q] *= rks * gk[128 + ax * 32 + q];
          if (tok < NLAT) {
            const int pos = ax == 0 ? (t >> 6) : (t & 63);
            const float* cs = p.w.cs + pos * 32;
#pragma unroll
            for (int i = 0; i < 16; ++i) {
              const float c = cs[i * 2], sn = cs[i * 2 + 1];
              const float x1 = pe[i], x2 = pe[16 + i];
              pe[i] = x1 * c - x2 * sn; pe[16 + i] = x2 * c + x1 * sn;
            }
          }
          uint4* dst = (uint4*)(p.w.k + (size_t)tok * 1536 + pn * 192 + 128 + ax * 32);
#pragma unroll
          for (int q = 0; q < 4; ++q) {
            uint4 o;
            o.x = pack2(pe[q * 8], pe[q * 8 + 1]); o.y = pack2(pe[q * 8 + 2], pe[q * 8 + 3]); o.z = pack2(pe[q * 8 + 4], pe[q * 8 + 5]); o.w = pack2(pe[q * 8 + 6], pe[q * 8 + 7]);
            dst[q] = o;
          }
        }
      }
      __syncthreads();
#pragma unroll
      for (int ai = 0; ai < 2; ++ai)
#pragma unroll
        for (int m = 0; m < 4; ++m) {
          const int rl = ai * 128 + wr * 64 + m * 16 + fr;
          const float sc = rkv[ai][m] * rk[rl];
          bf16* kd = p.w.k + (size_t)(brow + rl) * 1536 + pn * 192;
#pragma unroll
          for (int n = 0; n < 2; ++n) {
            const int col = wc * 32 + n * 16 + fq * 4;
            const float4 gg = *(const float4*)(gk + col);
            const f32x4 v = acc[ai][0][m][n];
            uint2 o; o.x = pack2(v[0] * sc * gg.x, v[1] * sc * gg.y); o.y = pack2(v[2] * sc * gg.z, v[3] * sc * gg.w);
            *(uint2*)(kd + col) = o;
          }
        }
    }
  }
};
__device__ __forceinline__ void mla_up_stream_phase(const P& p, char* shm, int bid, int nb, int wv, bool q_ctx) {
  FUp f(p, bid, nb, wv, q_ctx);
  gemm_stream(f, shm, wv);
}

struct MoeTile { int cls, tt, cnt, elo, ehi; };
constexpr int MOE_TAB = 131072;
__device__ __forceinline__ int moe_build_table(const int* cnt, char* shm, int wv) {
  int4* tinfo = (int4*)(shm + MOE_TAB);
  volatile int* ntp = (volatile int*)(shm + MOE_TAB + 2816);
  const int T = tidx(wv);
  __syncthreads();
  if (T < 24) {
    int base = 0;
    for (int c = 0; c < T; ++c) base += (cnt[c] + 255) >> 8;
    const int n = cnt[T], nt = (n + 255) >> 8;
    for (int k = 0; k < nt; ++k) tinfo[base + k] = make_int4(T, k, n, 0);
    if (T == 23) *ntp = base + nt;
  }
  __syncthreads();
  return __builtin_amdgcn_readfirstlane(*ntp);
}
__device__ __forceinline__ MoeTile moe_tile(const char* shm, int ti) {
  const int4 v = *(const int4*)(shm + MOE_TAB + ti * 16);
  MoeTile r; r.cls = __builtin_amdgcn_readfirstlane(v.x); r.tt = __builtin_amdgcn_readfirstlane(v.y); r.cnt = __builtin_amdgcn_readfirstlane(v.z);
  const int g = r.cls / 6, pi = r.cls % 6;
  const int a = pi < 3 ? 0 : (pi < 5 ? 1 : 2);
  const int b = pi < 3 ? pi + 1 : (pi < 5 ? pi - 1 : 3);
  r.elo = g * 4 + a; r.ehi = g * 4 + b;
  return r;
}

__device__ __forceinline__ void fmoe_up_phase(const P& p, char* shm, int bid, int nb, int wv) {
  const int ntile = moe_build_table(p.w.cnt, shm, wv);
  const XRange xr = xcd_range(bid, nb, ((ntile + 7) & ~7) * 12);
  for (int i = 0; i * xr.per < xr.size; ++i) {
    const int loc = i * xr.per + xr.off;
    if (loc >= xr.size) continue;
    const int Lq = xr.start + loc, g_ = Lq / 96, w_ = Lq - g_ * 96;
    const int ti = g_ * 8 + (w_ & 7), jn = w_ >> 3;
    if (ti >= ntile) continue;
    const int sidx = jn >> 2, jq = jn & 3;
    const MoeTile mt = moe_tile(shm, ti);
    const int eid = sidx == 0 ? 16 : (sidx == 1 ? mt.elo : mt.ehi);
    const int* lst = p.w.list + (size_t)mt.cls * NALL;
    const int rbase = mt.tt * 256;
    GemmIO io;
    io.A = (const bf16*)p.w.h8; io.B0 = (const bf16*)(p.w.W13q + (size_t)eid * 2 * 512 * 1024); io.B1 = io.B0; io.B2 = io.B0; io.nt = 8; io.ktper = 8;
    {
      int tz = tidx(wv); asm volatile("" : "+v"(tz));
      int R0, C0; stage_rc(tz * 16, R0, C0);
#pragma unroll
      for (int q = 0; q < 4; ++q) {
        int r = rbase + q * 64 + R0;
        int tok = lst[r < mt.cnt ? r : 0];
        io.a4[q] = (unsigned)(tok * 512 + C0);
      }
      io.a_h = 0; io.a_i = 0;
      io.b0 = (unsigned)((jq * 128 + R0) * 512 + C0); io.b_h = 512 * 512; io.b_i = 64 * 512;
    }
    Acc acc;
    zero_acc(acc);
    __syncthreads();
    gemm_core<true, true, 0, false, false, true>(io, shm, acc, wv);
    int T = tidx(wv); asm volatile("" : "+v"(T));
    const int wid = T >> 6, lane = T & 63, wr = wid >> 2, wc = wid & 3, fr = lane & 15, fq = lane >> 4;
    float4 swg[2], swu[2];
    {
      const float* swp = p.w.sw13 + (size_t)eid * 2 * 512 + jq * 128 + wc * 32 + fq * 4;
#pragma unroll
      for (int n = 0; n < 2; ++n) { swg[n] = *(const float4*)(swp + n * 16); swu[n] = *(const float4*)(swp + 512 + n * 16); }
    }
#pragma unroll
    for (int ai = 0; ai < 2; ++ai)
#pragma unroll
      for (int m = 0; m < 4; ++m) {
        const int row = ai * 128 + wr * 64 + m * 16 + fr;
        float coef = 1.f, sa;
        { int r = rbase + row; int tok = lst[r < mt.cnt ? r : 0]; sa = p.w.sa8[tok]; if (sidx != 0) coef = p.w.tok_w[tok * 2 + sidx - 1]; }
        const float sa2c = sa * sa * coef;
#pragma unroll
        for (int n = 0; n < 2; ++n) {
          const i32x4 gi = __builtin_bit_cast(i32x4, acc[ai][0][m][n]), ui = __builtin_bit_cast(i32x4, acc[ai][1][m][n]);
          const int col = sidx * 512 + jq * 128 + wc * 32 + n * 16 + fq * 4;
          const float g0 = (float)gi[0] * sa * swg[n].x, g1 = (float)gi[1] * sa * swg[n].y, g2 = (float)gi[2] * sa * swg[n].z, g3 = (float)gi[3] * sa * swg[n].w;
          const float u0 = (float)ui[0] * swu[n].x, u1 = (float)ui[1] * swu[n].y, u2 = (float)ui[2] * swu[n].z, u3 = (float)ui[3] * swu[n].w;
          const float sc2 = sa * coef;
          uint2 o;
          o.x = pack2(silu_f(g0) * u0 * sc2, silu_f(g1) * u1 * sc2);
          o.y = pack2(silu_f(g2) * u2 * sc2, silu_f(g3) * u3 * sc2);
          *(uint2*)(p.w.hid + ((size_t)ti * 256 + row) * 1536 + col) = o;
          (void)sa2c;
        }
      }
  }
}

__device__ __forceinline__ void fmoe_down_phase(const P& p, char* shm, int bid, int nb, int wv) {
  const int ntile = moe_build_table(p.w.cnt, shm, wv);
  const XRange xr = xcd_range(bid, nb, ((ntile + 7) & ~7) * 4);
  const int Fr = xr.size / xr.per, Rr = xr.size - Fr * xr.per;
  const bool split = Rr > 0 && 2 * Rr <= xr.per;
  auto body = [&](int ti, int pn, int half, auto halfTag) {
    constexpr bool HALF = decltype(halfTag)::value;
    const int bcol = pn * 256 + half * 128;
    const MoeTile mt = moe_tile(shm, ti);
    const int* lst = p.w.list + (size_t)mt.cls * NALL;
    const int rbase = mt.tt * 256;
    GemmIO io;
    io.A = p.w.hid + (size_t)ti * 256 * 1536;
    io.B0 = p.w.W2 + (size_t)16 * 1024 * 512; io.B1 = p.w.W2 + (size_t)mt.elo * 1024 * 512; io.B2 = p.w.W2 + (size_t)mt.ehi * 1024 * 512;
    io.nt = 24; io.ktper = 8;
    {
      int tz = tidx(wv); asm volatile("" : "+v"(tz));
      int R0, C0; stage_rc(tz * 16, R0, C0);
      io.a4[0] = (unsigned)(R0 * 1536 + C0); io.a_h = 128 * 1536; io.a_i = 64 * 1536;
      io.b0 = (unsigned)((bcol + R0) * 512 + C0); io.b_h = HALF ? 0 : 128 * 512; io.b_i = 64 * 512;
    }
    Acc acc;
    zero_acc(acc);
    __syncthreads();
    gemm_core<true, false, 8, HALF>(io, shm, acc, wv);
    int T = tidx(wv); asm volatile("" : "+v"(T));
    const int wid = T >> 6, lane = T & 63, wr = wid >> 2, wc = wid & 3, fr = lane & 15, fq = lane >> 4;
    constexpr int NBJ = HALF ? 1 : 2, NC = NBJ * 128;
    float* g2s = (float*)shm;
    {
      const float* g2 = p.w.mod + (size_t)p.layer * 17 * 6144 + 5 * 1024 + bcol;
      for (int e = T; e < 17 * NC; e += 512) { const int b = e / NC, c = e - b * NC; g2s[e] = g2[(size_t)b * 6144 + c]; }
    }
    int toks[2][4];
#pragma unroll
    for (int ai = 0; ai < 2; ++ai)
#pragma unroll
      for (int m = 0; m < 4; ++m) { const int r = rbase + ai * 128 + wr * 64 + m * 16 + fr; toks[ai][m] = r < mt.cnt ? lst[r] : -1; }
    asm volatile("" ::: "memory");
    bf16* xbase = (p.slot ? (bf16*)((char*)p.w.hid + ((size_t)200 << 20)) : p.w.xb);
    uint2 xin[2][4][NBJ][2];
#pragma unroll
    for (int ai = 0; ai < 2; ++ai)
#pragma unroll
      for (int m = 0; m < 4; ++m) {
        const int tok = toks[ai][m] < 0 ? 0 : toks[ai][m];
#pragma unroll
        for (int bj = 0; bj < NBJ; ++bj)
#pragma unroll
          for (int n = 0; n < 2; ++n) xin[ai][m][bj][n] = *(const uint2*)(xbase + (size_t)tok * 1024 + bcol + bj * 128 + wc * 32 + n * 16 + fq * 4);
      }
    __syncthreads();
#pragma unroll
    for (int ai = 0; ai < 2; ++ai)
#pragma unroll
      for (int m = 0; m < 4; ++m) {
        const int tok = toks[ai][m];
        if (tok >= 0) {
          const int mr = tok < NLAT ? tok / SEQ : 16;
#pragma unroll
          for (int bj = 0; bj < NBJ; ++bj)
#pragma unroll
            for (int n = 0; n < 2; ++n) {
              const f32x4 v = acc[ai][bj][m][n];
              const int cl = bj * 128 + wc * 32 + n * 16 + fq * 4;
              const float4 gg = *(const float4*)(g2s + mr * NC + cl);
              const uint2 u = xin[ai][m][bj][n];
              float4 xv = make_float4(bflo(u.x), bfhi(u.x), bflo(u.y), bfhi(u.y));
              xv.x += v[0] * gg.x; xv.y += v[1] * gg.y; xv.z += v[2] * gg.z; xv.w += v[3] * gg.w;
              if (p.layer == 3 && !p.slot) *(float4*)(p.X + (size_t)tok * 1024 + bcol + cl) = xv;
              else st_xb4(xbase + (size_t)tok * 1024 + bcol + cl, xv);
            }
        }
      }
  };
  for (int i = 0; i * xr.per < xr.size; ++i) {
    int Lq, half = 0; bool isHalf = false;
    if (split && i == Fr) {
      if (xr.off >= 2 * Rr) continue;
      Lq = xr.start + Fr * xr.per + (xr.off >> 1); half = xr.off & 1; isHalf = true;
    } else {
      const int loc = i * xr.per + xr.off;
      if (loc >= xr.size) continue;
      Lq = xr.start + loc;
    }
    const int g_ = Lq >> 5, w_ = Lq & 31;
    const int ti = g_ * 8 + (w_ & 7), pn = w_ >> 3;
    if (ti >= ntile) continue;
    if (isHalf) body(ti, pn, half, std::true_type{}); else body(ti, pn, 0, std::false_type{});
  }
}


using s16x4 = __attribute__((ext_vector_type(4))) short;
using f32x16 = __attribute__((ext_vector_type(16))) float;
using u32x4 = __attribute__((ext_vector_type(4))) unsigned;
constexpr int AT_LDQ = 1536, AT_LDK = 1536, AT_LDV = 1024, AT_LDO = 1024;
constexpr int AT_SHM_V = 64 * 128 * 2, AT_SHM_K = 64 * 192 * 2;
constexpr int AT_SHM = 2 * AT_SHM_V + 2 * AT_SHM_K + 8 * 64 * 4;
constexpr float AT_SCALE = 0.07216878364870322f;
constexpr float AT_THR = 8.f;
#define KSWZ(row, colB) ((row) * 384 + ((colB) ^ (((row) & 7) << 4)))
#define SBAR() __builtin_amdgcn_sched_barrier(0)
__device__ __forceinline__ int crow(int r, int hi) { return (r & 3) + 8 * (r >> 2) + 4 * hi; }

__device__ __forceinline__ void partialSM(f32x16& p0, f32x16& p1, float& m_reg, float& mn, float& alpha) {
  constexpr float C = AT_SCALE * 1.4426950408889634f;
  float pmax = p0[0];
#pragma unroll
  for (int r = 1; r < 16; ++r) pmax = fmaxf(pmax, p0[r]);
#pragma unroll
  for (int r = 0; r < 16; ++r) pmax = fmaxf(pmax, p1[r]);
  { auto rr = __builtin_amdgcn_permlane32_swap(__float_as_uint(pmax), __float_as_uint(pmax), false, false);
    pmax = fmaxf(__uint_as_float(rr[0]), __uint_as_float(rr[1])); }
  if (__builtin_expect(__all(pmax - m_reg <= AT_THR / AT_SCALE), 1)) { mn = m_reg; alpha = 1.f; }
  else { mn = fmaxf(m_reg, pmax); alpha = __builtin_amdgcn_exp2f((m_reg - mn) * C); m_reg = mn; }
  float mnC = -mn * C;
#pragma unroll
  for (int r = 0; r < 16; ++r) p0[r] = fmaf(p0[r], C, mnC);
#pragma unroll
  for (int r = 0; r < 16; ++r) p1[r] = fmaf(p1[r], C, mnC);
#pragma unroll
  for (int r = 0; r < 16; ++r) p0[r] = __builtin_amdgcn_exp2f(p0[r]);
}
__device__ __forceinline__ void finishSM(f32x16& p0, f32x16& p1, float alpha, float& l_reg, bf16x8& pa0, bf16x8& pa1, bf16x8& pa2, bf16x8& pa3) {
#pragma unroll
  for (int r = 0; r < 16; ++r) p1[r] = __builtin_amdgcn_exp2f(p1[r]);
  float ps = 0;
#pragma unroll
  for (int r = 0; r < 16; ++r) ps += p0[r];
#pragma unroll
  for (int r = 0; r < 16; ++r) ps += p1[r];
  { auto rr = __builtin_amdgcn_permlane32_swap(__float_as_uint(ps), __float_as_uint(ps), false, false);
    ps = __uint_as_float(rr[0]) + __uint_as_float(rr[1]); }
  l_reg = l_reg * alpha + ps;
#define PK4(PP, BASE, OUT) do { unsigned a0 = pack2(PP[BASE + 0], PP[BASE + 1]), a1 = pack2(PP[BASE + 2], PP[BASE + 3]);   \
    unsigned b0 = pack2(PP[BASE + 4], PP[BASE + 5]), b1 = pack2(PP[BASE + 6], PP[BASE + 7]);                              \
    auto r0 = __builtin_amdgcn_permlane32_swap(a0, b0, false, false); auto r1 = __builtin_amdgcn_permlane32_swap(a1, b1, false, false); \
    u32x4 w = {r0[0], r1[0], r0[1], r1[1]}; OUT = *reinterpret_cast<bf16x8*>(&w); } while (0)
  PK4(p0, 0, pa0); PK4(p0, 8, pa1); PK4(p1, 0, pa2); PK4(p1, 8, pa3);
#undef PK4
}
__device__ __forceinline__ void qkt(f32x16& p0, f32x16& p1, const char* kbase, const int (&kb4)[4], const bf16x8* qr) {
  p0 = f32x16{}; p1 = f32x16{};
#pragma unroll
  for (int d0 = 0; d0 < 12; ++d0) {
    const char* a0 = kbase + kb4[d0 & 3] + (d0 >> 2) * 1024;
    bf16x8 b0 = *reinterpret_cast<const bf16x8*>(a0);
    bf16x8 b1 = *reinterpret_cast<const bf16x8*>(a0 + 12288);
    p0 = __builtin_amdgcn_mfma_f32_32x32x16_bf16(b0, qr[d0], p0, 0, 0, 0);
    p1 = __builtin_amdgcn_mfma_f32_32x32x16_bf16(b1, qr[d0], p1, 0, 0, 0); }
}
__device__ __forceinline__ int v_st(int k, int c) { const int kk = (k & ~0xC) | ((k & 4) << 1) | ((k & 8) >> 1); return ((kk >> 3) * 4 + (c >> 5)) * 512 + ((kk & 7) * 32 + (c & 31)) * 2; }
__device__ __forceinline__ int v_rd_base(int lane) { return ((lane & 3) << 3) | (((lane >> 2) & 3) << 6) | (((lane >> 4) & 1) << 5) | (((lane >> 5) & 1) << 8); }
constexpr int v_rd_off(int d0, int ks, int half) { return d0 * 512 + ks * 4096 + half * 2048; }
template <int OFF> __device__ __forceinline__ s16x4 tr_read(int vb) {
  s16x4 r; asm volatile("ds_read_b64_tr_b16 %0, %1 offset:%2" : "=&v"(r) : "v"(vb), "i"(OFF) : "memory"); return r;
}
template <int D0> __device__ __forceinline__ void pv_one(f32x16& od, int vb, bf16x8 pa0, bf16x8 pa1, bf16x8 pa2, bf16x8 pa3) {
  const s16x4 l0 = tr_read<v_rd_off(D0, 0, 0)>(vb), h0 = tr_read<v_rd_off(D0, 0, 1)>(vb), l1 = tr_read<v_rd_off(D0, 1, 0)>(vb), h1 = tr_read<v_rd_off(D0, 1, 1)>(vb);
  const s16x4 l2 = tr_read<v_rd_off(D0, 2, 0)>(vb), h2 = tr_read<v_rd_off(D0, 2, 1)>(vb), l3 = tr_read<v_rd_off(D0, 3, 0)>(vb), h3 = tr_read<v_rd_off(D0, 3, 1)>(vb);
  asm volatile("s_waitcnt lgkmcnt(0)" ::: "memory"); SBAR();
#define PK(L, H) (bf16x8){L[0], L[1], L[2], L[3], H[0], H[1], H[2], H[3]}
  od = __builtin_amdgcn_mfma_f32_32x32x16_bf16(pa0, PK(l0, h0), od, 0, 0, 0);
  od = __builtin_amdgcn_mfma_f32_32x32x16_bf16(pa1, PK(l1, h1), od, 0, 0, 0);
  od = __builtin_amdgcn_mfma_f32_32x32x16_bf16(pa2, PK(l2, h2), od, 0, 0, 0);
  od = __builtin_amdgcn_mfma_f32_32x32x16_bf16(pa3, PK(l3, h3), od, 0, 0, 0);
#undef PK
}
__device__ __forceinline__ void pv_d0(f32x16* o, int vb, bf16x8 pa0, bf16x8 pa1, bf16x8 pa2, bf16x8 pa3) {
  pv_one<0>(o[0], vb, pa0, pa1, pa2, pa3); pv_one<1>(o[1], vb, pa0, pa1, pa2, pa3); pv_one<2>(o[2], vb, pa0, pa1, pa2, pa3); pv_one<3>(o[3], vb, pa0, pa1, pa2, pa3);
}

template <int NTL, int NTC>
__device__ __forceinline__ void attn_body(const bf16* __restrict__ Qb, const bf16* __restrict__ Kh, const bf16* __restrict__ Vh,
                                          bf16* __restrict__ Ob, int lat0, int ctx0, char* lds, int wv) {
  constexpr int NT = NTL + NTC;
  const int tid = tidx(wv), wid = tid >> 6, lane = tid & 63, r32 = lane & 31, hi = lane >> 5;
  char* V_lds = lds; char* K_lds = lds + 2 * AT_SHM_V;
  float* ws = (float*)(lds + 2 * AT_SHM_V + 2 * AT_SHM_K) + wid * 64; float* li_l = ws; float* al_l = ws + 32;
  float m_reg = -1e30f, l_reg = 0; f32x16 o[4] = {}; bf16x8 qr[12];
  const bf16* Qw = Qb + (size_t)(wid * 32 + r32) * AT_LDQ + hi * 8;
#pragma unroll
  for (int d0 = 0; d0 < 12; ++d0) qr[d0] = *reinterpret_cast<const bf16x8*>(Qw + d0 * 16);
  unsigned kg[3], vg[2];
#pragma unroll
  for (int i = 0; i < 3; ++i) { const int blk = wid + 8 * i, rg = blk / 3, cg = blk % 3, rowpos = lane >> 3, chunkpos = lane & 7;
    const int r = rg * 8 + (rowpos ^ (rg & 1)), c16 = cg * 8 + (chunkpos ^ (r & 7)); kg[i] = (unsigned)(r * AT_LDK + c16 * 8); }
#pragma unroll
  for (int i = 0; i < 2; ++i) { const int P_ = (wid + 8 * i) * 1024 + lane * 16; const int sub = P_ / 512, within = (P_ % 512) / 2;
    const int kk = (sub >> 2) * 8 + within / 32, c = (sub & 3) * 32 + (within & 31); const int k = (kk & ~0xC) | ((kk & 4) << 1) | ((kk & 8) >> 1);
    vg[i] = (unsigned)(k * AT_LDV + c); }
  const int vb0 = (int)(uintptr_t)V_lds + v_rd_base(lane);
  int kb4[4];
#pragma unroll
  for (int q = 0; q < 4; ++q) kb4[q] = (r32 >> 3) * 3072 + (((r32 & 7) ^ ((r32 >> 3) & 1)) << 7) + ((((q << 1) | hi) ^ (r32 & 7)) << 4);
#define TOK0(t) ((t) < NTL ? lat0 + (t) * 64 : ctx0 + ((t) - NTL) * 64)
#define ISSUE(t, buf) do { const int _t0 = TOK0(t); const bf16* _kp = Kh + (size_t)_t0 * AT_LDK; const bf16* _vp = Vh + (size_t)_t0 * AT_LDV; \
    _Pragma("unroll") for (int _i = 0; _i < 3; ++_i) GLDS(_kp + kg[_i], K_lds + (buf) * AT_SHM_K + (wid + 8 * _i) * 1024 + lane * 16); \
    _Pragma("unroll") for (int _i = 0; _i < 2; ++_i) GLDS(_vp + vg[_i], V_lds + (buf) * AT_SHM_V + (wid + 8 * _i) * 1024 + lane * 16); } while (0)
#define ISSUE_K(t, buf) do { const bf16* _kp = Kh + (size_t)TOK0(t) * AT_LDK; \
    _Pragma("unroll") for (int _i = 0; _i < 3; ++_i) GLDS(_kp + kg[_i], K_lds + (buf) * AT_SHM_K + (wid + 8 * _i) * 1024 + lane * 16); } while (0)
#define ISSUE_V(t, buf) do { const bf16* _vp = Vh + (size_t)TOK0(t) * AT_LDV; \
    _Pragma("unroll") for (int _i = 0; _i < 2; ++_i) GLDS(_vp + vg[_i], V_lds + (buf) * AT_SHM_V + (wid + 8 * _i) * 1024 + lane * 16); } while (0)
#define LANDED() do { asm volatile("s_waitcnt vmcnt(0)" ::: "memory"); __builtin_amdgcn_s_barrier(); } while (0)
#define ST_QK(buf) do { SBAR(); qkt(p0, p1, K_lds + (buf) * AT_SHM_K, kb4, qr); SBAR(); } while (0)
#define ST_SM() do { partialSM(p0, p1, m_reg, mn, al); finishSM(p0, p1, al, l_reg, pa0, pa1, pa2, pa3); \
    if (__any(al < 1.f)) { if (hi == 0) al_l[r32] = al; asm volatile("s_waitcnt lgkmcnt(0)" ::: "memory"); \
      _Pragma("unroll") for (int d = 0; d < 4; ++d) _Pragma("unroll") for (int r = 0; r < 16; ++r) o[d][r] *= al_l[crow(r, hi)]; } SBAR(); } while (0)
#define ST_PV(buf) do { pv_d0(o, vb0 + (buf) * AT_SHM_V, pa0, pa1, pa2, pa3); SBAR(); } while (0)
  f32x16 p0, p1; float mn, al; bf16x8 pa0, pa1, pa2, pa3;
  ISSUE_K(0, 0); ISSUE_V(0, 0); LANDED();
  if (wv < 4) {
#pragma unroll 1
    for (int j = 0; j < NT; ++j) {
      const int buf = j & 1;
      if (j + 1 < NT) ISSUE_K(j + 1, buf ^ 1);
      ST_QK(buf);
      __builtin_amdgcn_s_barrier();
      if (j + 1 < NT) ISSUE_V(j + 1, buf ^ 1);
      ST_SM();
      __builtin_amdgcn_s_barrier();
      ST_PV(buf);
      LANDED();
    }
  } else {
#pragma unroll 1
    for (int j = 0; j < NT; ++j) {
      const int buf = j & 1;
      if (j + 1 < NT) ISSUE_K(j + 1, buf ^ 1);
      if (j > 0) ST_PV(buf ^ 1);
      __builtin_amdgcn_s_barrier();
      if (j + 1 < NT) ISSUE_V(j + 1, buf ^ 1);
      ST_QK(buf);
      __builtin_amdgcn_s_barrier();
      ST_SM();
      LANDED();
    }
    ST_PV((NT - 1) & 1);
  }
#undef ISSUE_K
#undef ISSUE_V
#undef ST_QK
#undef ST_SM
#undef ST_PV
  if (hi == 0) li_l[r32] = l_reg; asm volatile("s_waitcnt lgkmcnt(0)" ::: "memory");
  bf16* Ow = Ob + (size_t)(wid * 32) * AT_LDO;
#pragma unroll
  for (int r = 0; r < 16; ++r) { const int orow = crow(r, hi); const float rli = __builtin_amdgcn_rcpf(li_l[orow]);
#pragma unroll
    for (int d0 = 0; d0 < 4; ++d0) Ow[(size_t)orow * AT_LDO + d0 * 32 + r32] = f2bf(o[d0][r] * rli); }
  __syncthreads();
#undef ISSUE
#undef LANDED
#undef TOK0
}

__device__ __forceinline__ void attn_phase(const P& p, char* shm, int bid, int nb, bool do_ctx, int wv) {
  const bf16* Vbase = p.w.v;
  for (int u = bid; u < 1024; u += nb) {
    const int x = u & 7, y = (u >> 3) & 31, r = u >> 8;
    const int qb = y & 7, pair = x * 4 + (y >> 3) + 32 * r;
    const int b = pair >> 3, h = pair & 7;
    const int q0 = b * SEQ + qb * 256;
    attn_body<32, 4>(p.w.q + (size_t)q0 * AT_LDQ + h * 192, p.w.k + h * 192, Vbase + h * 128, p.w.o + (size_t)q0 * AT_LDO + h * 128, b * SEQ, NLAT + b * CTX, shm, wv);
  }
  if (do_ctx) {
    for (int u = bid; u < 128; u += nb) {
      const int b = u >> 3, h = u & 7;
      const int q0 = NLAT + b * CTX;
      attn_body<0, 4>(p.w.q + (size_t)q0 * AT_LDQ + h * 192, p.w.k + h * 192, Vbase + h * 128, p.w.o + (size_t)q0 * AT_LDO + h * 128, 0, NLAT + b * CTX, shm, wv);
    }
  }
}


__device__ __forceinline__ void filter_phase(const P& p, char* shm, int bid, int nb, int wv) {
  float* wl = (float*)shm;
  float* vs = (float*)shm + 1024;
  const int T = tidx(wv), wid = T >> 6;
  for (int u = bid; u < 2 * 2 * 128; u += nb) {
    const int v = u >> 8, j = (u >> 7) & 1, c0 = (u & 127) * 8;
    const int L = v ? 256 : 2048, p0 = v ? 2048 : 0, xoff = v ? 4096 : 0;
    const int NI = v ? 1 : 4;
    const float* hf = p.w.hf + ((size_t)j * 2304 + p0) * 64;
    const float* w3 = p.hy_f_w3 + (size_t)j * 64 * 2048;
    const float min_decay = logf(1e-2f) / 1.5f, max_decay = logf(1e-2f) / 0.3f;
    __syncthreads();
    for (int e = T; e < 1024; e += 512) { const int n = e >> 4, q2 = e & 15; wl[e] = w3[n * 2048 + (q2 < 8 ? c0 + q2 : 1024 + c0 + q2 - 8)]; }
    __syncthreads();
    float asum[8];
#pragma unroll
    for (int q = 0; q < 8; ++q) asum[q] = 0.f;
#pragma unroll 1
    for (int i = 0; i < NI; ++i) {
      const int t = T + 512 * i;
      const bool act = t < L;
      float h[64];
      {
        const float4* h4 = (const float4*)(hf + (size_t)(act ? t : 0) * 64);
#pragma unroll
        for (int q = 0; q < 16; ++q) { const float4 x = h4[q]; h[q * 4] = x.x; h[q * 4 + 1] = x.y; h[q * 4 + 2] = x.z; h[q * 4 + 3] = x.w; }
      }
      float acc[16];
#pragma unroll
      for (int q = 0; q < 16; ++q) acc[q] = 0.f;
#pragma unroll
      for (int n = 0; n < 64; ++n) {
#pragma unroll
        for (int q4 = 0; q4 < 4; ++q4) {
          const float4 w = *(const float4*)(wl + n * 16 + q4 * 4);
          acc[q4 * 4] += h[n] * w.x; acc[q4 * 4 + 1] += h[n] * w.y; acc[q4 * 4 + 2] += h[n] * w.z; acc[q4 * 4 + 3] += h[n] * w.w;
        }
      }
      const float tn = (float)t / (float)(L - 1);
#pragma unroll
      for (int q = 0; q < 8; ++q) {
        const int c = c0 + q;
        const float ad = fabsf(min_decay + (float)c * ((max_decay - min_decay) / 1023.f));
        const float dec = expf(-tn * ad);
        float a = acc[q] * dec, b = acc[8 + q] * dec;
        if (!act) { a = 0.f; b = 0.f; }
        if (t == 0) b = 0.f;
        asum[q] += fabsf(a) + fabsf(b);
        vs[(i * 16 + q) * 512 + T] = a; vs[(i * 16 + 8 + q) * 512 + T] = b;
      }
    }
    __syncthreads();
#pragma unroll
    for (int q = 0; q < 8; ++q) { const float sv = wave_sum(asum[q]); if ((T & 63) == 0) wl[wid * 8 + q] = sv; }
    __syncthreads();
    float inv[8];
#pragma unroll
    for (int q = 0; q < 8; ++q) {
      float tot = 0.f;
#pragma unroll
      for (int w8 = 0; w8 < 8; ++w8) tot += wl[w8 * 8 + q];
      inv[q] = 1.f / tot;
    }
#pragma unroll 1
    for (int i = 0; i < NI; ++i) {
      const int t = T + 512 * i;
      if (t < L) {
#pragma unroll
        for (int q = 0; q < 8; ++q) {
          bf16* rf = p.w.rf + ((size_t)j * 1024 + c0 + q) * 4608 + xoff;
          rf[L - t] = f2bf(vs[(i * 16 + q) * 512 + T] * inv[q]);
          if (t >= 1) rf[L + t] = f2bf(vs[(i * 16 + 8 + q) * 512 + T] * inv[q]); else rf[0] = f2bf(0.f);
        }
      }
    }
  }
}

template <int NB8>
__device__ __forceinline__ void toep_wave(const char* ldsA, const char* ldsB, f32x4 (&acc)[16]) {
  bf16x8 ring[16]; bf16x8 bfr[2];
#pragma unroll
  for (int u = -15; u <= 0; ++u) ring[u & 15] = *(const bf16x8*)(ldsA + 32 + 32 * u);
  bfr[0] = *(const bf16x8*)(ldsB);
#pragma unroll 1
  for (int B = 0; B < NB8; ++B) {
#pragma unroll
    for (int bb = 0; bb < 8; ++bb) {
      acc[15] = __builtin_amdgcn_mfma_f32_16x16x32_bf16(ring[(2 * bb - 15) & 15], bfr[bb & 1], acc[15], 0, 0, 0);
      acc[14] = __builtin_amdgcn_mfma_f32_16x16x32_bf16(ring[(2 * bb - 14) & 15], bfr[bb & 1], acc[14], 0, 0, 0);
      if (bb < 7 || B + 1 < NB8) {
        ring[(2 * bb + 1) & 15] = *(const bf16x8*)(ldsA + 64 * bb + 64);
        ring[(2 * bb + 2) & 15] = *(const bf16x8*)(ldsA + 64 * bb + 96);
        bfr[(bb + 1) & 1] = *(const bf16x8*)(ldsB + 64 * (bb + 1));
      }
#pragma unroll
      for (int a = 13; a >= 0; --a)
        acc[a] = __builtin_amdgcn_mfma_f32_16x16x32_bf16(ring[(2 * bb - a) & 15], bfr[bb & 1], acc[a], 0, 0, 0);
      __builtin_amdgcn_sched_barrier(0);
    }
    ldsA += 512; ldsB += 512;
  }
}


__device__ __forceinline__ void conv8(const uint4 ch, float prev, float next, float w0, float w1, float w2, float bias, float (&out)[8]) {
  float u[10];
  u[0] = prev; u[1] = bflo(ch.x); u[2] = bfhi(ch.x); u[3] = bflo(ch.y); u[4] = bfhi(ch.y); u[5] = bflo(ch.z); u[6] = bfhi(ch.z); u[7] = bflo(ch.w); u[8] = bfhi(ch.w); u[9] = next;
#pragma unroll
  for (int i = 0; i < 8; ++i) out[i] = u[i] * w0 + u[i + 1] * w1 + u[i + 2] * w2 + bias;
}

template <int L>
__device__ __forceinline__ void toep_unit(const P& p, char* shm, int unit, int wv) {
  constexpr int TEAM = L == 2048 ? 512 : 64;
  constexpr int CS = 4 * L + 16, RS = 2 * L + 16;
  constexpr int REG = 16 * RS;
  static_assert(8 * CS <= REG, "region");
  constexpr int CPT = 16 * L / 8 / TEAM;
  int T = tidx(wv); asm volatile("" : "+v"(T));
  const int wid = T >> 6, lane = T & 63;
  const int tt = L == 2048 ? T : lane;
  const int cb0 = tt / (L / 8), ct8 = (tt % (L / 8)) * 8;
  const int ldsch = cb0 * RS + ct8 * 2, gch = cb0 * L + ct8;
  const int c = L == 2048 ? unit : unit * 8 + wid;
  char* RC = shm + (L == 2048 ? 0 : wid * 2 * REG);
  char* VG = RC + REG;
  const int tok0 = L == 2048 ? 0 : NLAT;
  const bf16* zx0 = p.w.zT + (size_t)c * NALL + tok0;
  const bf16* zx1 = p.w.zT + (size_t)(1024 + c) * NALL + tok0;
  const bf16* zv = p.w.zT + (size_t)(2048 + c) * NALL + tok0;
  const float* cw = p.hy_conv_w + (size_t)p.j * 3 * 3072;
  const float* cb = p.hy_conv_b + (size_t)p.j * 3072;
  __syncthreads();
  {
    const bf16* rf = p.w.rf + ((size_t)p.j * 1024 + c) * 4608 + (L == 2048 ? 0 : 4096);
    constexpr int NCH = 2 * L / 8;
    const uint4 lo = *(const uint4*)(rf + tt * 8);
    uint4 hi4 = make_uint4(0, 0, 0, 0);
    if (tt + 1 < NCH) hi4 = *(const uint4*)(rf + tt * 8 + 8);
    const unsigned in[9] = {lo.x, lo.y, lo.z, lo.w, hi4.x, hi4.y, hi4.z, hi4.w, 0u};
#pragma unroll
    for (int k = 0; k < 8; ++k) {
      unsigned o4[4];
#pragma unroll
      for (int i = 0; i < 4; ++i) {
        const unsigned a = in[i + k / 2], b = in[i + k / 2 + 1];
        o4[i] = (k & 1) ? ((a >> 16) | (b << 16)) : a;
      }
      *(uint4*)(RC + k * CS + tt * 16) = make_uint4(o4[0], o4[1], o4[2], o4[3]);
    }
  }
  {
    const float w10 = cw[1024 + c], w11 = cw[3072 + 1024 + c], w12 = cw[2 * 3072 + 1024 + c], b1 = cb[1024 + c];
    const float wv0 = cw[2048 + c], wv1 = cw[3072 + 2048 + c], wv2 = cw[2 * 3072 + 2048 + c], bv = cb[2048 + c];
#pragma unroll 2
    for (int q = 0; q < CPT; ++q) {
      const int t8 = ct8;
      const size_t off = (size_t)(gch + q * 2 * L);
      const uint4 c1 = *(const uint4*)(zx1 + off), cv = *(const uint4*)(zv + off);
      float p1 = 0.f, n1 = 0.f, pv = 0.f, nv = 0.f;
      if (t8 > 0) { p1 = bf2f(zx1[off - 1]); pv = bf2f(zv[off - 1]); }
      if (t8 + 8 < L) { n1 = bf2f(zx1[off + 8]); nv = bf2f(zv[off + 8]); }
      float o1[8], ov[8];
      conv8(c1, p1, n1, w10, w11, w12, b1, o1);
      conv8(cv, pv, nv, wv0, wv1, wv2, bv, ov);
      uint4 r;
      r.x = pack2(o1[0] * ov[0], o1[1] * ov[1]); r.y = pack2(o1[2] * ov[2], o1[3] * ov[3]);
      r.z = pack2(o1[4] * ov[4], o1[5] * ov[5]); r.w = pack2(o1[6] * ov[6], o1[7] * ov[7]);
      *(uint4*)(VG + ldsch + q * 2 * RS) = r;
    }
  }
  static_assert(CPT == 8, "8 chunks per thread");
#define X0LD(q) const uint4 x0r##q = *(const uint4*)(zx0 + gch + q * 2 * L)
  X0LD(0); X0LD(1); X0LD(2); X0LD(3); X0LD(4); X0LD(5); X0LD(6); X0LD(7);
#undef X0LD
  __syncthreads();
  const int i16 = lane & 15, g = lane >> 4;
  const int tw = L == 2048 ? wid * 256 : 0;
  f32x4 acc[16];
#pragma unroll
  for (int a = 0; a < 16; ++a) acc[a] = f32x4{0.f, 0.f, 0.f, 0.f};
  {
    const int cpy = (8 - (i16 & 7)) & 7, ru8 = i16 + cpy;
    const char* ldsA = RC + cpy * CS + 2 * (L + 8 * g - ru8) - 2 * tw - 32;
    const char* ldsB = VG + i16 * RS + 16 * g;
    toep_wave<L / 256>(ldsA, ldsB, acc);
  }
  __syncthreads();
#define X0ST(q) *(uint4*)(RC + ldsch + q * 2 * RS) = x0r##q
  X0ST(0); X0ST(1); X0ST(2); X0ST(3); X0ST(4); X0ST(5); X0ST(6); X0ST(7);
#undef X0ST
  __syncthreads();
  {
    const float w00 = cw[c], w01 = cw[3072 + c], w02 = cw[2 * 3072 + c], b0 = cb[c];
    const float fb = p.hy_f_bias[p.j * 1024 + c];
    const int b = i16;
#pragma unroll
    for (int a = 0; a < 16; ++a) {
      const int t = tw + 16 * a + 4 * g;
      const char* xr = RC + b * RS + t * 2;
      const uint2 xc = *(const uint2*)xr;
      const float xp = t > 0 ? bf2f(*(const bf16*)(xr - 2)) : 0.f;
      const float xn = t + 4 < L ? bf2f(*(const bf16*)(xr + 8)) : 0.f;
      const float x0 = bflo(xc.x), x1 = bfhi(xc.x), x2 = bflo(xc.y), x3 = bfhi(xc.y);
      const float c0 = xp * w00 + x0 * w01 + x1 * w02 + b0;
      const float c1 = x0 * w00 + x1 * w01 + x2 * w02 + b0;
      const float c2 = x1 * w00 + x2 * w01 + x3 * w02 + b0;
      const float c3 = x2 * w00 + x3 * w01 + xn * w02 + b0;
      char* vr = VG + b * RS + t * 2;
      const uint2 vv = *(const uint2*)vr;
      uint2 o;
      o.x = pack2((acc[a][0] + bflo(vv.x) * fb) * c0, (acc[a][1] + bfhi(vv.x) * fb) * c1);
      o.y = pack2((acc[a][2] + bflo(vv.y) * fb) * c2, (acc[a][3] + bfhi(vv.y) * fb) * c3);
      *(uint2*)vr = o;
    }
  }
  __syncthreads();
  {
    bf16* dst = p.w.ygT + (size_t)c * NALL + tok0;
#pragma unroll
    for (int q = 0; q < CPT; ++q) *(uint4*)(dst + gch + q * 2 * L) = *(const uint4*)(VG + ldsch + q * 2 * RS);
  }
}

__device__ __forceinline__ void toep_steps8(bf16x8 (&ring)[16], bf16x8 (&bfr)[2], f32x4 (&acc)[16], const char* ldsA, const char* ldsB, bool more) {
#pragma unroll
  for (int bb = 0; bb < 8; ++bb) {
    acc[15] = __builtin_amdgcn_mfma_f32_16x16x32_bf16(ring[(2 * bb - 15) & 15], bfr[bb & 1], acc[15], 0, 0, 0);
    acc[14] = __builtin_amdgcn_mfma_f32_16x16x32_bf16(ring[(2 * bb - 14) & 15], bfr[bb & 1], acc[14], 0, 0, 0);
    if (bb < 7 || more) {
      ring[(2 * bb + 1) & 15] = *(const bf16x8*)(ldsA + 64 * bb + 64);
      ring[(2 * bb + 2) & 15] = *(const bf16x8*)(ldsA + 64 * bb + 96);
    }
    if (bb < 7) bfr[(bb + 1) & 1] = *(const bf16x8*)(ldsB + 64 * (bb + 1));
#pragma unroll
    for (int a = 13; a >= 0; --a)
      acc[a] = __builtin_amdgcn_mfma_f32_16x16x32_bf16(ring[(2 * bb - a) & 15], bfr[bb & 1], acc[a], 0, 0, 0);
    __builtin_amdgcn_sched_barrier(0);
  }
}

__device__ __forceinline__ void toep_unit_lat(const P& p, char* shm, int c, int wv) {
  constexpr int L = 2048;
  constexpr int CS = 4 * L + 16, RS = 2 * L + 16, REG = 16 * RS;
  int T = tidx(wv); asm volatile("" : "+v"(T));
  const int wid = T >> 6, lane = T & 63;
  const int cb0 = T >> 8, ct8 = (T & 255) * 8;
  const int ldsch = cb0 * RS + ct8 * 2, gch = cb0 * L + ct8;
  const int bb_ = T >> 5, bt8 = (T & 31) * 8;
  const int lblk = bb_ * RS + bt8 * 2, gblk = bb_ * L + bt8;
  char* RC = shm; char* VG = RC + REG;
  const bf16* zx0 = p.w.zT + (size_t)c * NALL;
  const bf16* zx1 = p.w.zT + (size_t)(1024 + c) * NALL;
  const bf16* zv = p.w.zT + (size_t)(2048 + c) * NALL;
  const float* cw = p.hy_conv_w + (size_t)p.j * 3 * 3072;
  const float* cb = p.hy_conv_b + (size_t)p.j * 3072;
  const float w10 = cw[1024 + c], w11 = cw[3072 + 1024 + c], w12 = cw[2 * 3072 + 1024 + c], b1 = cb[1024 + c];
  const float wv0 = cw[2048 + c], wv1 = cw[3072 + 2048 + c], wv2 = cw[2 * 3072 + 2048 + c], bv = cb[2048 + c];
#define BLK_LOAD(S, k) do { const int o_ = gblk + (k) * 256; const int t_ = (k) * 256 + bt8; \
    S##c1 = *(const uint4*)(zx1 + o_); S##cv = *(const uint4*)(zv + o_); \
    const int op_ = t_ > 0 ? o_ - 1 : o_; const int on_ = t_ + 8 < L ? o_ + 8 : o_; \
    S##p1 = *(const unsigned short*)(zx1 + op_); S##pv = *(const unsigned short*)(zv + op_); \
    S##n1 = *(const unsigned short*)(zx1 + on_); S##nv = *(const unsigned short*)(zv + on_); } while (0)
#define BLK_CONV(S, k) do { const int t_ = (k) * 256 + bt8; \
    const float fp1 = t_ > 0 ? __uint_as_float((unsigned)S##p1 << 16) : 0.f, fpv = t_ > 0 ? __uint_as_float((unsigned)S##pv << 16) : 0.f; \
    const float fn1 = t_ + 8 < L ? __uint_as_float((unsigned)S##n1 << 16) : 0.f, fnv = t_ + 8 < L ? __uint_as_float((unsigned)S##nv << 16) : 0.f; \
    float o1[8], ov[8]; conv8(S##c1, fp1, fn1, w10, w11, w12, b1, o1); conv8(S##cv, fpv, fnv, wv0, wv1, wv2, bv, ov); \
    uint4 r_; r_.x = pack2(o1[0] * ov[0], o1[1] * ov[1]); r_.y = pack2(o1[2] * ov[2], o1[3] * ov[3]); \
    r_.z = pack2(o1[4] * ov[4], o1[5] * ov[5]); r_.w = pack2(o1[6] * ov[6], o1[7] * ov[7]); \
    *(uint4*)(VG + lblk + (k) * 512) = r_; } while (0)
  uint4 Ac1, Acv, Bc1, Bcv; unsigned short Ap1, Apv, An1, Anv, Bp1, Bpv, Bn1, Bnv;
  __syncthreads();
  BLK_LOAD(A, 0); BLK_LOAD(B, 1);
  {
    const bf16* rf = p.w.rf + ((size_t)p.j * 1024 + c) * 4608;
    const uint4 lo = *(const uint4*)(rf + T * 8);
    uint4 hi4 = make_uint4(0, 0, 0, 0);
    if (T + 1 < 512) hi4 = *(const uint4*)(rf + T * 8 + 8);
    const unsigned in[9] = {lo.x, lo.y, lo.z, lo.w, hi4.x, hi4.y, hi4.z, hi4.w, 0u};
#pragma unroll
    for (int k = 0; k < 8; ++k) {
      unsigned o4[4];
#pragma unroll
      for (int i = 0; i < 4; ++i) { const unsigned a = in[i + k / 2], b = in[i + k / 2 + 1]; o4[i] = (k & 1) ? ((a >> 16) | (b << 16)) : a; }
      *(uint4*)(RC + k * CS + T * 16) = make_uint4(o4[0], o4[1], o4[2], o4[3]);
    }
  }
  BLK_CONV(A, 0);
#define X0LD(q) const uint4 x0r##q = *(const uint4*)(zx0 + gch + q * 2 * L)
  X0LD(0); X0LD(1); X0LD(2); X0LD(3); X0LD(4); X0LD(5); X0LD(6); X0LD(7);
#undef X0LD
  const int i16 = lane & 15, g = lane >> 4;
  const int tw = wid * 256;
  f32x4 acc[16];
#pragma unroll
  for (int a = 0; a < 16; ++a) acc[a] = f32x4{0.f, 0.f, 0.f, 0.f};
  const int cpy = (8 - (i16 & 7)) & 7, ru8 = i16 + cpy;
  const char* ldsA = RC + cpy * CS + 2 * (L + 8 * g - ru8) - 2 * tw - 32;
  const char* ldsB = VG + i16 * RS + 16 * g;
  bf16x8 ring[16]; bf16x8 bfr[2];
  __syncthreads();
#pragma unroll
  for (int u = -15; u <= 0; ++u) ring[u & 15] = *(const bf16x8*)(ldsA + 32 + 32 * u);
#pragma unroll 1
  for (int k = 0; k < 8; k += 2) {
    if (k + 2 < 8) BLK_LOAD(A, k + 2);
    bfr[0] = *(const bf16x8*)(ldsB);
    toep_steps8(ring, bfr, acc, ldsA, ldsB, true);
    ldsA += 512; ldsB += 512;
    BLK_CONV(B, k + 1);
    __syncthreads();
    if (k + 3 < 8) BLK_LOAD(B, k + 3);
    bfr[0] = *(const bf16x8*)(ldsB);
    toep_steps8(ring, bfr, acc, ldsA, ldsB, k + 2 < 8);
    ldsA += 512; ldsB += 512;
    if (k + 2 < 8) BLK_CONV(A, k + 2);
    __syncthreads();
  }
#undef BLK_LOAD
#undef BLK_CONV
#define X0ST(q) *(uint4*)(RC + ldsch + q * 2 * RS) = x0r##q
  X0ST(0); X0ST(1); X0ST(2); X0ST(3); X0ST(4); X0ST(5); X0ST(6); X0ST(7);
#undef X0ST
  __syncthreads();
  {
    const float w00 = cw[c], w01 = cw[3072 + c], w02 = cw[2 * 3072 + c], b0 = cb[c];
    const float fb = p.hy_f_bias[p.j * 1024 + c];
    const int b = i16;
#pragma unroll
    for (int a = 0; a < 16; ++a) {
      const int t = tw + 16 * a + 4 * g;
      const char* xr = RC + b * RS + t * 2;
      const uint2 xc = *(const uint2*)xr;
      const float xp = t > 0 ? bf2f(*(const bf16*)(xr - 2)) : 0.f;
      const float xn = t + 4 < L ? bf2f(*(const bf16*)(xr + 8)) : 0.f;
      const float x0 = bflo(xc.x), x1 = bfhi(xc.x), x2 = bflo(xc.y), x3 = bfhi(xc.y);
      const float c0 = xp * w00 + x0 * w01 + x1 * w02 + b0;
      const float c1 = x0 * w00 + x1 * w01 + x2 * w02 + b0;
      const float c2 = x1 * w00 + x2 * w01 + x3 * w02 + b0;
      const float c3 = x2 * w00 + x3 * w01 + xn * w02 + b0;
      char* vr = VG + b * RS + t * 2;
      const uint2 vv = *(const uint2*)vr;
      uint2 o;
      o.x = pack2((acc[a][0] + bflo(vv.x) * fb) * c0, (acc[a][1] + bfhi(vv.x) * fb) * c1);
      o.y = pack2((acc[a][2] + bflo(vv.y) * fb) * c2, (acc[a][3] + bfhi(vv.y) * fb) * c3);
      *(uint2*)vr = o;
    }
  }
  __syncthreads();
  {
    bf16* dst = p.w.ygT + (size_t)c * NALL;
#pragma unroll
    for (int q = 0; q < 8; ++q) *(uint4*)(dst + gch + q * 2 * L) = *(const uint4*)(VG + ldsch + q * 2 * RS);
  }
}
constexpr int TOEP_SHM = 2 * 16 * (2 * 2048 + 16);
constexpr int TOEP_SHM_C = 8 * 2 * 16 * (2 * 256 + 16);
__device__ __forceinline__ void toep_phase(const P& p, char* shm, int bid, int nb, int wv) {
  for (int u = bid; u < 1024; u += nb) toep_unit_lat(p, shm, u, wv);
  for (int u = bid; u < 128; u += nb) toep_unit<256>(p, shm, u, wv);
}

__device__ __forceinline__ void transpose_phase(const P& p, char* shm, int bid, int nb, int wv) {
  unsigned short* tile = (unsigned short*)shm;
  float* red = (float*)(shm + 65536);
  const int T = tidx(wv);
  const int tok = T & 31, cg = T >> 5;
  for (int u = bid; u < NALL / 32; u += nb) {
    const int t0 = u * 32;
    __syncthreads();
#pragma unroll
    for (int q = 0; q < 8; ++q) {
      const int ch = (T >> 2) + q * 128, k8 = (T & 3) * 8;
      *(uint4*)(tile + ch * 32 + k8) = *(const uint4*)(p.w.ygT + (size_t)ch * NALL + t0 + k8);
    }
    __syncthreads();
    float am = 0.f;
#pragma unroll 8
    for (int c = 0; c < 64; ++c) am = fmaxf(am, fabsf(__uint_as_float((unsigned)tile[(cg * 64 + c) * 32 + tok] << 16)));
    red[cg * 32 + tok] = am;
    __syncthreads();
    if (T < 32) {
      float m = 0.f;
#pragma unroll
      for (int q = 0; q < 16; ++q) m = fmaxf(m, red[q * 32 + T]);
      const float sc = m > 0.f ? m * (1.f / 127.f) : 1.f;
      p.w.syg[t0 + T] = sc;
      red[512 + T] = 1.f / sc;
    }
    __syncthreads();
    const float inv = red[512 + tok];
    unsigned ow[16];
#pragma unroll
    for (int w4 = 0; w4 < 16; ++w4) {
      unsigned pk = 0;
#pragma unroll
      for (int e = 0; e < 4; ++e) {
        const float v = __uint_as_float((unsigned)tile[(cg * 64 + w4 * 4 + e) * 32 + tok] << 16);
        pk |= ((unsigned)((int)rintf(v * inv) & 255)) << (8 * e);
      }
      ow[w4] = pk;
    }
    uint4* dst = (uint4*)(p.w.yg8 + (size_t)(t0 + tok) * 1024 + cg * 64);
#pragma unroll
    for (int q = 0; q < 4; ++q) dst[q] = make_uint4(ow[q * 4], ow[q * 4 + 1], ow[q * 4 + 2], ow[q * 4 + 3]);
  }
}


#define XB_TMO      128
#define XB_XCNT(j)  (256  + 64 * (j))
#define XB_XSUB(j)  (1280 + 64 * (j))
#define XB_XGEN(j)  (2304 + 64 * (j))
#define XB_TOP      3328
#define XB_TOPGEN   3392
#define XCD_BAR_WORDS 3456
#define XB_SPIN_CAP (1u << 22)
#define LAS __attribute__((address_space(3)))
__device__ __forceinline__ unsigned xb_ld(unsigned* p)              { return __hip_atomic_load(p, __ATOMIC_RELAXED, __HIP_MEMORY_SCOPE_AGENT); }
__device__ __forceinline__ unsigned xb_add(unsigned* p, unsigned v) { return __hip_atomic_fetch_add(p, v, __ATOMIC_RELAXED, __HIP_MEMORY_SCOPE_AGENT); }
__device__ __forceinline__ unsigned xb_xcc_id() { return (unsigned)__builtin_amdgcn_s_getreg((3 << 11) | 20) & 0xFu; }
#define XB_SPIN(cond, bar) do { unsigned _sp = 0; while (cond) { __builtin_amdgcn_s_sleep(1); \
    if ((++_sp & 255u) == 0u) { if (xb_ld(&(bar)[XB_TMO])) break; if (_sp > XB_SPIN_CAP) { atomicAdd(&(bar)[XB_TMO], 1u); break; } } } } while (0)
struct XcdBarrier { unsigned* bar; unsigned x; volatile LAS unsigned* st; };
__device__ __forceinline__ XcdBarrier xcd_barrier_post(unsigned* bar, volatile LAS unsigned* st) {
  XcdBarrier b; b.bar = bar; b.x = xb_xcc_id(); b.st = st;
  if (threadIdx.x == 0) (void)xb_add(&bar[XB_XCNT(b.x)], 1u);
  return b;
}
__device__ __forceinline__ void xcd_barrier_complete(unsigned* bar, unsigned x, unsigned& nloc, unsigned& nx) {
  const unsigned G = gridDim.x * gridDim.y * gridDim.z;
  unsigned sum, cnt, mine, sp = 0u;
  for (;;) {
    sum = 0u; cnt = 0u; mine = 0u;
#pragma unroll
    for (unsigned j = 0; j < 16; ++j) { const unsigned c = xb_ld(&bar[XB_XCNT(j)]); sum += c; cnt += (c > 0u) ? 1u : 0u; mine = (j == x) ? c : mine; }
    if (sum == G) break;
    __builtin_amdgcn_s_sleep(1);
    if ((++sp & 255u) == 0u) { if (xb_ld(&bar[XB_TMO])) break; if (sp > XB_SPIN_CAP) { atomicAdd(&bar[XB_TMO], 1u); break; } }
  }
  nloc = mine > 0u ? mine : 1u; nx = cnt > 0u ? cnt : 1u;
}
__device__ __forceinline__ void xcd_barrier(const XcdBarrier& b, int wv) {
  asm volatile("s_waitcnt vmcnt(0)" ::: "memory");
  __syncthreads();
  if (tidx(wv) == 0) {
    unsigned* bar = b.bar;
    __builtin_amdgcn_s_waitcnt(0);
    unsigned nloc = b.st[0], nx = b.st[1];
    if (nloc == 0u) { xcd_barrier_complete(bar, b.x, nloc, nx); b.st[0] = nloc; b.st[1] = nx; }
    const unsigned old = xb_add(&bar[XB_XSUB(b.x)], 1u);
    const unsigned gen = old / nloc;
    if (old + 1u == (gen + 1u) * nloc) {
      __builtin_amdgcn_fence(__ATOMIC_RELEASE, "agent");
      asm volatile("s_waitcnt vmcnt(0)" ::: "memory");
      const unsigned og = xb_add(&bar[XB_TOP], 1u);
      const unsigned tg = og / nx;
      if (og + 1u == (tg + 1u) * nx) xb_add(&bar[XB_TOPGEN], 1u);
      else XB_SPIN(xb_ld(&bar[XB_TOPGEN]) == tg, bar);
      __builtin_amdgcn_fence(__ATOMIC_ACQUIRE, "agent");
      xb_add(&bar[XB_XGEN(b.x)], 1u);
      asm volatile("s_waitcnt vmcnt(0)" ::: "memory");
    } else {
      XB_SPIN(xb_ld(&bar[XB_XGEN(b.x)]) == gen, bar);
      __builtin_amdgcn_fence(__ATOMIC_ACQUIRE, "agent");
      asm volatile("s_waitcnt vmcnt(0)" ::: "memory");
    }
  }
  __syncthreads();
}

__device__ __forceinline__ void mod_phase(const P& p, char* shm, int bid, int nb, int wv) {
  float* sl = (float*)shm;
  const int T = tidx(wv);
  for (int u = bid; u < 4 * 12 * 16; u += nb) {
    const int i = u / 192, rem = u % 192, nblk = rem >> 4, ks = rem & 15;
    __syncthreads();
    for (int e = T; e < 17 * 64; e += 512) {
      const int r = e >> 6, k = e & 63;
      const float v = r < 16 ? p.c[r * 1024 + ks * 64 + k] : p.c_ctx[ks * 64 + k];
      sl[e] = silu_f(v);
    }
    __syncthreads();
    const int n = nblk * 512 + T;
    float acc[17];
#pragma unroll
    for (int r = 0; r < 17; ++r) acc[r] = 0.f;
    const float* wp = p.ada_w + ((size_t)i * 1024 + ks * 64) * 6144 + n;
#pragma unroll 1
    for (int k0 = 0; k0 < 64; k0 += 16) {
      float wv16[16];
#pragma unroll
      for (int k = 0; k < 16; ++k) wv16[k] = wp[(size_t)(k0 + k) * 6144];
#pragma unroll
      for (int k = 0; k < 16; ++k)
#pragma unroll
        for (int r = 0; r < 17; ++r) acc[r] += sl[r * 64 + k0 + k] * wv16[k];
    }
#pragma unroll
    for (int r = 0; r < 17; ++r) p.w.modp[(((size_t)ks * 4 + i) * 17 + r) * 6144 + n] = acc[r];
  }
}
__device__ __forceinline__ void modreduce_phase(const P& p, int bid, int nb, int wv) {
  constexpr int TOT = 4 * 17 * 6144;
  for (int idx = bid * 512 + tidx(wv); idx < TOT; idx += nb * 512) {
    const int i = idx / (17 * 6144), n = idx % 6144;
    float a = p.ada_b[i * 6144 + n];
#pragma unroll
    for (int ks = 0; ks < 16; ++ks) a += p.w.modp[(size_t)ks * TOT + idx];
    p.w.mod[idx] = a;
  }
}
__device__ __forceinline__ void fhid_phase(const P& p, int bid, int nb, int wv) {
  const int wid = tidx(wv) >> 6, n = tidx(wv) & 63;
  for (int u = bid * 8 + wid; u < 2 * 2304; u += nb * 8) {
    const int j = u / 2304, pp = u % 2304;
    const int L = pp < 2048 ? 2048 : 256;
    const int t = pp < 2048 ? pp : pp - 2048;
    float zn = 0.f;
    if (n == 0) zn = (float)t / (float)(L - 1);
    else if (n < 33) {
      const int bi = (n - 1) % 16;
      const double band = 1e-4 + (double)bi * ((15.0 - 1e-4) / 15.0);
      double x = band * (double)t / (double)L;
      x -= floor(x);
      const float xf = (float)x;
      zn = n <= 16 ? cospif(2.f * xf) : -sinpif(2.f * xf);
    }
    const float fr = p.hy_sin_freq[j * 64 + n];
    float a = p.hy_f_b1[j * 64 + n];
    for (int k = 0; k < 33; ++k) a += __int_as_float(__builtin_amdgcn_readlane(__float_as_int(zn), k)) * p.hy_f_w1[(j * 33 + k) * 64 + n];
    float hv = sinf(fr * a);
    for (int m = 0; m < 2; ++m) {
      a = p.hy_f_b2[(j * 2 + m) * 64 + n];
      for (int k = 0; k < 64; ++k) a += __int_as_float(__builtin_amdgcn_readlane(__float_as_int(hv), k)) * p.hy_f_w2[((size_t)(j * 2 + m) * 64 + k) * 64 + n];
      hv = sinf(fr * a);
    }
    p.w.hf[((size_t)j * 2304 + pp) * 64 + n] = hv;
  }
}
__device__ __forceinline__ void ropetab_phase(const P& p, int bid, int nb, int wv) {
  for (int gid = bid * 512 + tidx(wv); gid < 64 * 16; gid += nb * 512) {
    const int pos = gid / 16, i = gid % 16;
    const double inv = pow(10000.0, -(double)(2 * i) / 32.0);
    const double a = (double)pos * inv;
    p.w.cs[gid * 2] = (float)cos(a);
    p.w.cs[gid * 2 + 1] = (float)sin(a);
  }
}

__device__ __forceinline__ void norm_mix_phase(const P& p, int bid, int nb, int wv) {
  const int wid = tidx(wv) >> 6, lane = tidx(wv) & 63;
  const float* g = p.norm_mix_g + p.layer * 1024;
  for (int rb = (bid * 8 + wid) * 4; rb < NALL; rb += nb * 32) {
    float4 v[4][4];
#pragma unroll
    for (int r = 0; r < 4; ++r) {
      const int row = rb + r;
      if (p.layer == 0) {
        const float* xr = row < NLAT ? p.x + (size_t)row * 1024 : p.ctx + (size_t)(row - NLAT) * 1024;
#pragma unroll
        for (int i = 0; i < 4; ++i) v[r][i] = *(const float4*)(xr + lane * 4 + 256 * i);
      } else {
        const bf16* xr = p.w.xb + (size_t)row * 1024;
#pragma unroll
        for (int i = 0; i < 4; ++i) v[r][i] = ld_xb4(xr + lane * 4 + 256 * i);
      }
    }
    const float* mod = modrow(p, rb);
    float4 sh[4], sc[4], gg[4];
#pragma unroll
    for (int i = 0; i < 4; ++i) { const int col = lane * 4 + 256 * i; sh[i] = *(const float4*)(mod + col); sc[i] = *(const float4*)(mod + 1024 + col); gg[i] = *(const float4*)(g + col); }
#pragma unroll
    for (int r = 0; r < 4; ++r) {
      const int row = rb + r;
      float ss = 0.f;
#pragma unroll
      for (int i = 0; i < 4; ++i) ss += v[r][i].x * v[r][i].x + v[r][i].y * v[r][i].y + v[r][i].z * v[r][i].z + v[r][i].w * v[r][i].w;
      ss = wave_sum(ss);
      const float rstd = rsqrtf(ss / 1024.f + EPS);
      float hv[16], am = 0.f;
#pragma unroll
      for (int i = 0; i < 4; ++i) {
        hv[i * 4 + 0] = v[r][i].x * rstd * gg[i].x * (1.f + sc[i].x) + sh[i].x; hv[i * 4 + 1] = v[r][i].y * rstd * gg[i].y * (1.f + sc[i].y) + sh[i].y;
        hv[i * 4 + 2] = v[r][i].z * rstd * gg[i].z * (1.f + sc[i].z) + sh[i].z; hv[i * 4 + 3] = v[r][i].w * rstd * gg[i].w * (1.f + sc[i].w) + sh[i].w;
      }
#pragma unroll
      for (int q = 0; q < 16; ++q) am = fmaxf(am, fabsf(hv[q]));
      am = wave_max(am);
      const float qs = am > 0.f ? am * (1.f / 127.f) : 1.f, inv = 1.f / qs;
      if (lane == 0) p.w.sa8[row] = qs;
#pragma unroll
      for (int i = 0; i < 4; ++i) {
        const int q0 = (int)rintf(hv[i * 4] * inv), q1 = (int)rintf(hv[i * 4 + 1] * inv), q2 = (int)rintf(hv[i * 4 + 2] * inv), q3 = (int)rintf(hv[i * 4 + 3] * inv);
        *(unsigned*)(p.w.h8 + (size_t)row * 1024 + lane * 4 + 256 * i) = (unsigned)(q0 & 255) | ((unsigned)(q1 & 255) << 8) | ((unsigned)(q2 & 255) << 16) | ((unsigned)(q3 & 255) << 24);
      }
    }
  }
}

__device__ __forceinline__ void router_prep_phase(const P& p, int bid, int nb, int wv) {
  const int wid = tidx(wv) >> 6, lane = tidx(wv) & 63;
  const float* g = p.norm_ffn_g + p.layer * 1024;
  for (int u = bid * 8 + wid; u < 17 * 32 + 17 * 16; u += nb * 8) {
    if (u < 17 * 32) {
      const int b = u >> 5, ks = u & 31, e = lane & 15, k0 = ks * 32 + (lane >> 4) * 8;
      const float* sc = p.w.mod + ((size_t)p.layer * 17 + b) * 6144 + 4 * 1024;
      unsigned hi[4], lo[4];
#pragma unroll
      for (int jj = 0; jj < 4; ++jj) {
        float m[2]; unsigned short h2[2], l2[2];
#pragma unroll
        for (int q = 0; q < 2; ++q) {
          const int col = k0 + jj * 2 + q;
          m[q] = g[col] * (1.f + sc[col]) * p.router_w[col * 16 + e];
          const bf16 hb = f2bf(m[q]); const float hf32 = bf2f(hb); const bf16 lb = f2bf(m[q] - hf32);
          h2[q] = *(const unsigned short*)&hb; l2[q] = *(const unsigned short*)&lb;
        }
        hi[jj] = (unsigned)h2[0] | ((unsigned)h2[1] << 16); lo[jj] = (unsigned)l2[0] | ((unsigned)l2[1] << 16);
      }
      p.w.mfrag[((size_t)(b * 32 + ks) * 2 + 0) * 64 + lane] = make_uint4(hi[0], hi[1], hi[2], hi[3]);
      p.w.mfrag[((size_t)(b * 32 + ks) * 2 + 1) * 64 + lane] = make_uint4(lo[0], lo[1], lo[2], lo[3]);
    } else {
      const int q = u - 17 * 32, b = q >> 4, e = q & 15;
      const float* sh = p.w.mod + ((size_t)p.layer * 17 + b) * 6144 + 3 * 1024;
      float a = 0.f;
#pragma unroll
      for (int i = 0; i < 16; ++i) { const int col = lane + 64 * i; a += sh[col] * p.router_w[col * 16 + e]; }
      a = wave_sum(a);
      if (lane == 0) p.w.rbias[b * 16 + e] = a;
    }
  }
}

__device__ __forceinline__ void norm_ffn_phase(const P& p, char* shm, int bid, int nb, int wv) {
  float* rstd_l = (float*)shm;
  float* lgs = (float*)(shm + 1024);
  int* lcnt = (int*)(shm + 1024 + 8192);
  int* lbase = lcnt + 32;
  int* rinfo = lbase + 32;
  const int T = tidx(wv), wid = T >> 6, lane = T & 63;
  const int rpb = (p.nrows + nb - 1) / nb;
  const int row0 = bid * rpb;
  const int rend = min(row0 + rpb, p.nrows);
  __syncthreads();
  if (T < 32) lcnt[T] = 0;
  const float* g = p.norm_ffn_g + p.layer * 1024;
  for (int rb = row0 + wid * 4; rb < rend; rb += 32) {
    float4 v[4][4];
#pragma unroll
    for (int r = 0; r < 4; ++r) {
      const int rr = rb + r < rend ? rb + r : rb;
      const bf16* xr = p.w.xb + (size_t)rr * 1024;
#pragma unroll
      for (int i = 0; i < 4; ++i) v[r][i] = ld_xb4(xr + lane * 4 + 256 * i);
    }
    const float* mod = modrow(p, rb);
    float4 sh[4], sc[4], gg[4];
#pragma unroll
    for (int i = 0; i < 4; ++i) { const int col = lane * 4 + 256 * i; sh[i] = *(const float4*)(mod + 3 * 1024 + col); sc[i] = *(const float4*)(mod + 4 * 1024 + col); gg[i] = *(const float4*)(g + col); }
#pragma unroll
    for (int r = 0; r < 4; ++r) {
      const int row = rb + r;
      const bool valid = row < rend;
      float ss = 0.f;
#pragma unroll
      for (int i = 0; i < 4; ++i) ss += v[r][i].x * v[r][i].x + v[r][i].y * v[r][i].y + v[r][i].z * v[r][i].z + v[r][i].w * v[r][i].w;
      ss = wave_sum(ss);
      const float rstd = rsqrtf(ss / 1024.f + EPS);
      float hv[16], am = 0.f;
#pragma unroll
      for (int i = 0; i < 4; ++i) {
        hv[i * 4 + 0] = v[r][i].x * rstd * gg[i].x * (1.f + sc[i].x) + sh[i].x; hv[i * 4 + 1] = v[r][i].y * rstd * gg[i].y * (1.f + sc[i].y) + sh[i].y;
        hv[i * 4 + 2] = v[r][i].z * rstd * gg[i].z * (1.f + sc[i].z) + sh[i].z; hv[i * 4 + 3] = v[r][i].w * rstd * gg[i].w * (1.f + sc[i].w) + sh[i].w;
      }
#pragma unroll
      for (int q = 0; q < 16; ++q) am = fmaxf(am, fabsf(hv[q]));
      am = wave_max(am);
      const float qs = am > 0.f ? am * (1.f / 127.f) : 1.f, inv = 1.f / qs;
      if (valid) {
        if (lane == 0) { p.w.sa8[row] = qs; rstd_l[row - row0] = rstd; }
#pragma unroll
        for (int i = 0; i < 4; ++i) {
          const int q0 = (int)rintf(hv[i * 4] * inv), q1 = (int)rintf(hv[i * 4 + 1] * inv), q2 = (int)rintf(hv[i * 4 + 2] * inv), q3 = (int)rintf(hv[i * 4 + 3] * inv);
          *(unsigned*)(p.w.h8 + (size_t)row * 1024 + lane * 4 + 256 * i) = (unsigned)(q0 & 255) | ((unsigned)(q1 & 255) << 8) | ((unsigned)(q2 & 255) << 16) | ((unsigned)(q3 & 255) << 24);
        }
      }
    }
  }
  __syncthreads();
  for (int t0 = row0 + wid * 16; t0 < rend; t0 += 128) {
    const int bidx = t0 < NLAT ? t0 / SEQ : 16;
    const int ar = min(t0 + (lane & 15), rend - 1);
    const bf16* xa = p.w.xb + (size_t)ar * 1024 + (lane >> 4) * 8;
    const uint4* mf = p.w.mfrag + (size_t)bidx * 32 * 2 * 64 + lane;
    f32x4 acc = f32x4{0.f, 0.f, 0.f, 0.f};
#pragma unroll 8
    for (int ks = 0; ks < 32; ++ks) {
      const bf16x8 a = *(const bf16x8*)(xa + ks * 32);
      const uint4 bh = mf[(ks * 2) * 64], bl = mf[(ks * 2 + 1) * 64];
      acc = __builtin_amdgcn_mfma_f32_16x16x32_bf16(a, __builtin_bit_cast(bf16x8, bh), acc, 0, 0, 0);
      acc = __builtin_amdgcn_mfma_f32_16x16x32_bf16(a, __builtin_bit_cast(bf16x8, bl), acc, 0, 0, 0);
    }
    const float rb_e = p.w.rbias[bidx * 16 + (lane & 15)];
#pragma unroll
    for (int r = 0; r < 4; ++r) {
      const int rr = 4 * (lane >> 4) + r;
      const float rs = rstd_l[min(t0 + rr, rend - 1) - row0];
      lgs[(wid * 16 + rr) * 16 + (lane & 15)] = acc[r] * rs + rb_e;
    }
    __builtin_amdgcn_fence(__ATOMIC_RELEASE, "wavefront");
    if (lane < 16 && t0 + lane < rend) {
      const int row = t0 + lane;
      float sg[16], sb[16];
#pragma unroll
      for (int e = 0; e < 16; ++e) { const float a = lgs[(wid * 16 + lane) * 16 + e]; sg[e] = 1.f / (1.f + expf(-a)); sb[e] = sg[e] + p.router_bias[e]; }
      int gsel = 0; float gbest = -1e30f;
#pragma unroll
      for (int gi = 0; gi < 4; ++gi) {
        float m1 = -1e30f, m2 = -1e30f;
#pragma unroll
        for (int q = 0; q < 4; ++q) { const float t = sb[gi * 4 + q]; if (t > m1) { m2 = m1; m1 = t; } else if (t > m2) m2 = t; }
        const float gs = m1 + m2;
        if (gs > gbest) { gbest = gs; gsel = gi; }
      }
      float vb[4], vs[4];
#pragma unroll
      for (int q = 0; q < 4; ++q) { vb[q] = sb[q]; vs[q] = sg[q]; }
#pragma unroll
      for (int gi = 1; gi < 4; ++gi)
#pragma unroll
        for (int q = 0; q < 4; ++q) if (gsel == gi) { vb[q] = sb[gi * 4 + q]; vs[q] = sg[gi * 4 + q]; }
      int e1 = 0; float b1 = vb[0];
#pragma unroll
      for (int q = 1; q < 4; ++q) if (vb[q] > b1) { b1 = vb[q]; e1 = q; }
      int e2 = -1; float b2 = -1e30f;
#pragma unroll
      for (int q = 0; q < 4; ++q) if (q != e1 && vb[q] > b2) { b2 = vb[q]; e2 = q; }
      const int a = min(e1, e2), b = max(e1, e2);
      float wlo = vs[0], whi = vs[1];
#pragma unroll
      for (int q = 1; q < 4; ++q) { if (a == q) wlo = vs[q]; if (b == q) whi = vs[q]; }
      if (b == 0) whi = vs[0];
      const float nrm = 1.f / (wlo + whi);
      const int pairidx = a == 0 ? b - 1 : (a == 1 ? b + 1 : 5);
      const int cls = gsel * 6 + pairidx;
      p.w.tok_w[row * 2] = wlo * nrm; p.w.tok_w[row * 2 + 1] = whi * nrm;
      const int lr = atomicAdd(&lcnt[cls], 1);
      rinfo[row - row0] = (cls << 16) | lr;
    }
  }
  __syncthreads();
  if (T < 24) lbase[T] = (lcnt[T] && !p.slot) ? atomicAdd(&p.w.cnt[T], lcnt[T]) : 0;
  __syncthreads();
  for (int r = T; r < rend - row0; r += 512) {
    const int info = rinfo[r], cls = info >> 16, lr = info & 0xffff;
    if (!p.slot) p.w.list[(size_t)cls * NALL + lbase[cls] + lr] = row0 + r;
  }
}

struct CvtJob { const float* src; bf16* dst; const float* kscale; long s1, s2, d1, d2; int K, N, ld_dst, nb1, nb2, ks1, rowmap, tile0; };
struct CvtJobs { CvtJob j[8]; int total; int nj; };
__device__ __forceinline__ void cvt_tile(const float* src, int N, bf16* dst, int ld_dst, const float* ks, int rowmap, int k0, int n0, bf16* tile, int wv) {
  const int T = tidx(wv);
  __syncthreads();
#pragma unroll
  for (int i = 0; i < 2; ++i) {
    const int kk = (T >> 4) + i * 32, n4 = (T & 15) * 4;
    const float4 v = *(const float4*)(src + (size_t)(k0 + kk) * N + n0 + n4);
    const float sc = ks ? ks[k0 + kk] : 1.f;
    tile[(n4 + 0) * 72 + kk] = f2bf(v.x * sc); tile[(n4 + 1) * 72 + kk] = f2bf(v.y * sc);
    tile[(n4 + 2) * 72 + kk] = f2bf(v.z * sc); tile[(n4 + 3) * 72 + kk] = f2bf(v.w * sc);
  }
  __syncthreads();
  {
    const int nn = T >> 3, k8 = (T & 7) * 8;
    int drow = n0 + nn;
    if (rowmap) drow = (drow / 192) * 256 + drow % 192;
    *(uint4*)(dst + (size_t)drow * ld_dst + k0 + k8) = *(const uint4*)(tile + nn * 72 + k8);
  }
}
__device__ __forceinline__ void cvt_phase(const CvtJobs& cj, char* shm, int bid, int nb, int wv) {
  bf16* tile = (bf16*)shm;
  for (int t = bid; t < cj.total; t += nb) {
    int ji = 0;
#pragma unroll 1
    for (int q = 1; q < cj.nj; ++q) if (t >= cj.j[q].tile0) ji = q;
    const CvtJob& J = cj.j[ji];
    int lt = t - J.tile0;
    const int tn = J.N / 64, tk = J.K / 64, per = tn * tk;
    const int bi = lt / per; lt -= bi * per;
    const int b1 = bi / J.nb2, b2 = bi % J.nb2;
    const int k0 = (lt / tn) * 64, n0 = (lt % tn) * 64;
    cvt_tile(J.src + b1 * J.s1 + b2 * J.s2, J.N, J.dst + b1 * J.d1 + b2 * J.d2, J.ld_dst, J.kscale ? J.kscale + b1 * J.ks1 : nullptr, J.rowmap, k0, n0, tile, wv);
  }
}
__device__ __forceinline__ void cvt_w13_strip(const float* src, signed char* dst, float* sw, int n0, char* shm, int wv, int ldn = 512) {
  float* cmax = (float*)shm;
  unsigned char* tile8 = (unsigned char*)shm + 8192 + 256;
  const int T = tidx(wv), kq = T >> 4, n4 = (T & 15) * 4;
  float m0 = 0.f, m1 = 0.f, m2 = 0.f, m3 = 0.f;
#pragma unroll 4
  for (int c = 0; c < 32; ++c) {
    const float4 v = *(const float4*)(src + (size_t)(c * 32 + kq) * ldn + n0 + n4);
    m0 = fmaxf(m0, fabsf(v.x)); m1 = fmaxf(m1, fabsf(v.y)); m2 = fmaxf(m2, fabsf(v.z)); m3 = fmaxf(m3, fabsf(v.w));
  }
  __syncthreads();
  *(float4*)(cmax + kq * 64 + n4) = make_float4(m0, m1, m2, m3);
  __syncthreads();
  if (T < 64) {
    float m = 0.f;
#pragma unroll
    for (int q = 0; q < 32; ++q) m = fmaxf(m, cmax[q * 64 + T]);
    const float sc = m > 0.f ? m * (1.f / 127.f) : 1.f;
    sw[n0 + T] = sc;
    cmax[32 * 64 + T] = 1.f / sc;
  }
  __syncthreads();
  const float4 inv = *(const float4*)(cmax + 32 * 64 + n4);
#pragma unroll 1
  for (int k0 = 0; k0 < 1024; k0 += 64) {
#pragma unroll
    for (int i = 0; i < 2; ++i) {
      const int kk = kq + i * 32;
      const float4 v = *(const float4*)(src + (size_t)(k0 + kk) * ldn + n0 + n4);
      tile8[(n4 + 0) * 72 + kk] = (unsigned char)((int)rintf(v.x * inv.x) & 255); tile8[(n4 + 1) * 72 + kk] = (unsigned char)((int)rintf(v.y * inv.y) & 255);
      tile8[(n4 + 2) * 72 + kk] = (unsigned char)((int)rintf(v.z * inv.z) & 255); tile8[(n4 + 3) * 72 + kk] = (unsigned char)((int)rintf(v.w * inv.w) & 255);
    }
    __syncthreads();
    { const int nn = T >> 3, k8 = (T & 7) * 8;
      *(uint2*)(dst + (size_t)(n0 + nn) * 1024 + k0 + k8) = *(const uint2*)(tile8 + nn * 72 + k8); }
    __syncthreads();
  }
}
__device__ __forceinline__ void cvt_strips_phase(const P& p, char* shm, int bid, int nb, int wv) {
  for (int it = bid; it < 150; it += nb) {
    if (it >= 118) {
      const int q = it - 118, j = q >> 4, st = q & 15;
      cvt_w13_strip(p.hy_out_w + (size_t)j * 1024 * 1024, p.w.W_hyout8 + (size_t)j * 1024 * 1024, p.w.s_hyout + j * 1024, st * 64, shm, wv, 1024);
    } else if (it < 96) {
      const int j = it / 48, st = it % 48;
      cvt_w13_strip(p.hy_in_w + (size_t)j * 1024 * 3072, p.w.W_hyin8 + (size_t)j * 3072 * 1024, p.w.s_hyin + j * 3072, st * 64, shm, wv, 3072);
    } else {
      const int q = it - 96, j = q / 11, st = q % 11;
      if (st < 6) cvt_w13_strip(p.mla_wq_down + (size_t)j * 1024 * 384, p.w.W_mdown8 + (size_t)j * 768 * 1024, p.w.s_mdown + j * 768, st * 64, shm, wv, 384);
      else cvt_w13_strip(p.mla_wkv_down + (size_t)j * 1024 * 320, p.w.W_mdown8 + ((size_t)j * 768 + 384) * 1024, p.w.s_mdown + j * 768 + 384, (st - 6) * 64, shm, wv, 320);
    }
  }
}
__device__ __forceinline__ void cvt_moe_phase(const P& p, char* shm, unsigned* queue, int wv) {
  bf16* tile = (bf16*)shm;
  volatile int* slot = (volatile int*)(shm + SHM_SLOT);
  const long HM = 512L * 1024;
  for (;;) {
    __syncthreads();
    if (tidx(wv) == 0) *slot = (int)__hip_atomic_fetch_add(queue, 1u, __ATOMIC_RELAXED, __HIP_MEMORY_SCOPE_AGENT);
    __syncthreads();
    const int it = *slot;
    if (it >= 408) break;
    if (it < 272) {
      const int mat = it >> 3, strip = it & 7, q = mat / 17, e = mat % 17;
      const float* src = q == 0 ? (e < 16 ? p.exp_w1 + ((size_t)p.layer * 16 + e) * HM : p.sh_w1 + (size_t)p.layer * HM)
                                : (e < 16 ? p.exp_w3 + ((size_t)p.layer * 16 + e) * HM : p.sh_w3 + (size_t)p.layer * HM);
      cvt_w13_strip(src, p.w.W13q + ((size_t)e * 2 + q) * HM, p.w.sw13 + (e * 2 + q) * 512, strip * 64, shm, wv);
    } else {
      const int t0 = (it - 272) * 16;
#pragma unroll 1
      for (int t = t0; t < t0 + 16; ++t) {
        const int e = t >> 7, lt = t & 127;
        const float* src = e < 16 ? p.exp_w2 + ((size_t)p.layer * 16 + e) * HM : p.sh_w2 + (size_t)p.layer * HM;
        cvt_tile(src, 1024, p.w.W2 + (size_t)e * HM, 512, nullptr, 0, (lt / 16) * 64, (lt % 16) * 64, tile, wv);
      }
    }
  }
}

constexpr int SHM_MAIN = TOEP_SHM_C;
constexpr int SHM_TOTAL = SHM_MAIN + 32;
static_assert(SHM_SLOT == SHM_MAIN + 16, "slot");
static_assert(SHM_MAIN >= GEMM_SHM && SHM_MAIN >= AT_SHM && SHM_MAIN >= TOEP_SHM, "LDS budget");
struct MP { P p; CvtJobs gj; unsigned* bar; unsigned* pad; };
typedef __attribute__((address_space(4))) const MP* MPK;
__device__ __forceinline__ MPK kargs() { MPK q = (MPK)__builtin_amdgcn_kernarg_segment_ptr(); asm volatile("" : "+s"(q)); return q; }
#if defined(__HIP_DEVICE_COMPILE__)
#define PH(LAYER, NROWS, CALL) do { P p = kargs()->p; p.layer = (LAYER); p.j = (LAYER) >> 1; p.nrows = (NROWS); p.slot = 0; CALL; } while (0)
#define PHD(LAYER, NROWS, CALL) do { P p = kargs()->p; p.layer = (LAYER); p.j = (LAYER) >> 1; p.nrows = (NROWS); p.slot = 1; CALL; } while (0)
#else
#define PHD(LAYER, NROWS, CALL) do { } while (0)
#define PH(LAYER, NROWS, CALL) do { } while (0)
#endif

constexpr int DUP_HYIN = 1, DUP_TOEP = 1, DUP_TR = 1, DUP_MDOWN = 1, DUP_UP = 1, DUP_ATTN = 1, DUP_MOEUP = 1, DUP_NORM = 1, DUP_CVT = 1, DUP_BAR = 0, DUP_PRO = 1, DUP_HYOUT = 1, DUP_WO = 1, DUP_NFFN = 1, DUP_MOEDOWN = 1;

template <int I>
__device__ __forceinline__ void layer_body(char* dynshm, int bid, int nb, const XcdBarrier& bar, int wv) {
  constexpr bool need_ctx = I < 3;
  constexpr int NR = need_ctx ? NALL : NLAT;
  PH(I, NALL, { const int t_ = tidx(wv); if (bid == 0 && t_ < 32) p.w.cnt[t_] = 0; if constexpr ((I & 1) == 1) { for (int q = bid * 512 + t_; q < 2 * NALL; q += nb * 512) p.w.ssq[q] = 0.f; } norm_mix_phase(p, bid, nb, wv); router_prep_phase(p, bid, nb, wv); });
  if constexpr (DUP_NORM > 1) PH(I, NALL, norm_mix_phase(p, bid, nb, wv));
  xcd_barrier(bar, wv);
  if constexpr (DUP_BAR > 0) { for (int q = 0; q < DUP_BAR; ++q) xcd_barrier(bar, wv); }
  if constexpr ((I & 1) == 0) {
    PH(I, NALL, fgemm_phase<F_HYIN>(p, dynshm, bid, nb, wv));
    xcd_barrier(bar, wv);
    if constexpr (DUP_HYIN == 2) { PH(I, NALL, fgemm_phase<F_HYIN>(p, dynshm, bid, nb, wv)); xcd_barrier(bar, wv); }
    if constexpr (DUP_HYIN == 3) { PHD(I, NALL, fgemm_phase<F_HYIN>(p, dynshm, bid, nb, wv)); xcd_barrier(bar, wv); }
    PH(I, NALL, toep_phase(p, dynshm, bid, nb, wv));
    xcd_barrier(bar, wv);
    if constexpr (DUP_TOEP == 2) { PH(I, NALL, toep_phase(p, dynshm, bid, nb, wv)); xcd_barrier(bar, wv); }
    if constexpr (DUP_TOEP == 3) { PHD(I, NALL, toep_phase(p, dynshm, bid, nb, wv)); xcd_barrier(bar, wv); }
    PH(I, NALL, transpose_phase(p, dynshm, bid, nb, wv));
    xcd_barrier(bar, wv);
    if constexpr (DUP_TR > 1) { PH(I, NALL, transpose_phase(p, dynshm, bid, nb, wv)); xcd_barrier(bar, wv); }
    if constexpr (DUP_HYOUT > 1) { PHD(I, NALL, fgemm_phase<F_HYOUT>(p, dynshm, bid, nb, wv)); xcd_barrier(bar, wv); }
    PH(I, NALL, fgemm_phase<F_HYOUT>(p, dynshm, bid, nb, wv));
    PH(I, NALL, cvt_moe_phase(p, dynshm, kargs()->bar + 8 + I, wv));
    xcd_barrier(bar, wv);
  } else {
    PH(I, NALL, fgemm_phase<F_MDOWN>(p, dynshm, bid, nb, wv));
    xcd_barrier(bar, wv);
    if constexpr (DUP_MDOWN > 1) { PH(I, NALL, fgemm_phase<F_MDOWN>(p, dynshm, bid, nb, wv)); xcd_barrier(bar, wv); }
    PH(I, NALL, mla_up_stream_phase(p, dynshm, bid, nb, wv, need_ctx));
    xcd_barrier(bar, wv);
    if constexpr (DUP_UP > 1) { PH(I, NALL, mla_up_phase(p, dynshm, bid, nb, wv, need_ctx)); xcd_barrier(bar, wv); }
    PH(I, NALL, attn_phase(p, dynshm, bid, nb, need_ctx, wv));
    xcd_barrier(bar, wv);
    if constexpr (DUP_ATTN > 1) { PH(I, NALL, attn_phase(p, dynshm, bid, nb, need_ctx, wv)); xcd_barrier(bar, wv); }
    if constexpr (DUP_WO > 1) { PHD(I, NR, fgemm_phase<F_WO>(p, dynshm, bid, nb, wv)); xcd_barrier(bar, wv); }
    PH(I, NR, fgemm_phase<F_WO>(p, dynshm, bid, nb, wv));
    PH(I, NALL, cvt_moe_phase(p, dynshm, kargs()->bar + 8 + I, wv));
    xcd_barrier(bar, wv);
  }
  if constexpr (DUP_NFFN > 1) { PHD(I, NR, norm_ffn_phase(p, dynshm, bid, nb, wv)); xcd_barrier(bar, wv); }
  PH(I, NALL, cvt_moe_phase(p, dynshm, kargs()->bar + 8 + I, wv));
  PH(I, NR, norm_ffn_phase(p, dynshm, bid, nb, wv));
  xcd_barrier(bar, wv);
  PH(I, NR, fmoe_up_phase(p, dynshm, bid, nb, wv));
  xcd_barrier(bar, wv);
  if constexpr (DUP_MOEUP > 1) { PH(I, NR, fmoe_up_phase(p, dynshm, bid, nb, wv)); xcd_barrier(bar, wv); }
  if constexpr (DUP_MOEDOWN > 1) { PHD(I, NR, fmoe_down_phase(p, dynshm, bid, nb, wv)); xcd_barrier(bar, wv); }
  PH(I, NR, fmoe_down_phase(p, dynshm, bid, nb, wv));
  xcd_barrier(bar, wv);
}

__global__ void __launch_bounds__(512, 2) mega(MP mp) {
  extern __shared__ __attribute__((aligned(16))) char dynshm[];
  const int bid = blockIdx.x, nb = gridDim.x;
  const int wv = __builtin_amdgcn_readfirstlane((int)(threadIdx.x >> 6));
  uint4* xbw = (uint4*)(dynshm + SHM_MAIN);
  if (threadIdx.x == 0) *xbw = make_uint4(0u, 0u, 0u, 0u);
  __syncthreads();
  XcdBarrier bar = xcd_barrier_post(mp.bar, (volatile LAS unsigned*)xbw);
  PH(0, NALL, mod_phase(p, dynshm, bid, nb, wv));
  PH(0, NALL, fhid_phase(p, bid, nb, wv));
  PH(0, NALL, ropetab_phase(p, bid, nb, wv));
  cvt_phase(mp.gj, dynshm, bid, nb, wv);
  PH(0, NALL, cvt_strips_phase(p, dynshm, bid, nb, wv));
  xcd_barrier(bar, wv);
  PH(0, NALL, modreduce_phase(p, bid, nb, wv));
  PH(0, NALL, filter_phase(p, dynshm, bid, nb, wv));
  xcd_barrier(bar, wv);
  if constexpr (DUP_PRO == 2) { PH(0, NALL, mod_phase(p, dynshm, bid, nb, wv)); xcd_barrier(bar, wv); }
  if constexpr (DUP_PRO == 3) { PH(0, NALL, fhid_phase(p, bid, nb, wv)); xcd_barrier(bar, wv); }
  if constexpr (DUP_PRO == 4) { cvt_phase(mp.gj, dynshm, bid, nb, wv); xcd_barrier(bar, wv); }
  if constexpr (DUP_PRO == 5) { PH(0, NALL, filter_phase(p, dynshm, bid, nb, wv)); xcd_barrier(bar, wv); }
  layer_body<0>(dynshm, bid, nb, bar, wv);
  layer_body<1>(dynshm, bid, nb, bar, wv);
  layer_body<2>(dynshm, bid, nb, bar, wv);
  layer_body<3>(dynshm, bid, nb, bar, wv);
}

static char* carve(char*& cur, size_t bytes) { char* r = cur; cur += (bytes + 255) / 256 * 256; return r; }

extern "C" void kernel_launch(void* const* d_in, const int* in_sizes, int n_in, void* d_out, int out_size, void* d_ws, size_t ws_size,
                              hipStream_t stream) {
  MP mp{};
  P& p = mp.p;
  const float** fp = (const float**)&p.x;
  for (int i = 0; i < 38; ++i) fp[i] = (const float*)d_in[i];
  p.X = (float*)d_out;
  char* cur = (char*)d_ws;
  WS& w = p.w;
  mp.bar = (unsigned*)carve(cur, XCD_BAR_WORDS * 4);
  w.mod = (float*)carve(cur, (size_t)4 * 17 * 6144 * 4);
  w.xb = (bf16*)carve(cur, (size_t)NALL * 1024 * 2);
  w.h = (bf16*)carve(cur, (size_t)NALL * 1024 * 2);
  w.hf = (float*)carve(cur, (size_t)2 * 2304 * 64 * 4);
  w.rf = (bf16*)carve(cur, (size_t)2 * 1024 * 4608 * 2);
  w.cs = (float*)carve(cur, 64 * 16 * 2 * 4);
  w.cnt = (int*)carve(cur, 32 * 4);
  w.list = (int*)carve(cur, (size_t)24 * NALL * 4);
  w.tok_e = nullptr;
  w.tok_w = (float*)carve(cur, (size_t)NALL * 2 * 4);
  w.W_hyin8 = (signed char*)carve(cur, (size_t)2 * 3072 * 1024);
  w.s_hyin = (float*)carve(cur, (size_t)2 * 3072 * 4);
  w.W_hyout8 = (signed char*)carve(cur, (size_t)2 * 1024 * 1024);
  w.s_hyout = (float*)carve(cur, (size_t)2 * 1024 * 4);
  w.syg = (float*)carve(cur, (size_t)NALL * 4);
  w.W_mdown8 = (signed char*)carve(cur, (size_t)2 * 768 * 1024);
  w.s_mdown = (float*)carve(cur, (size_t)2 * 768 * 4);
  w.W_qup = (bf16*)carve(cur, (size_t)2 * 2048 * 384 * 2);
  w.W_kvup = (bf16*)carve(cur, (size_t)2 * 2048 * 256 * 2);
  w.W_wo = (bf16*)carve(cur, (size_t)2 * 1024 * 1024 * 2);
  w.W13q = (signed char*)carve(cur, (size_t)17 * 2 * 512 * 1024);
  w.sw13 = (float*)carve(cur, (size_t)17 * 2 * 512 * 4);
  w.h8 = (signed char*)carve(cur, (size_t)NALL * 1024);
  w.sa8 = (float*)carve(cur, (size_t)NALL * 4);
  w.mfrag = (uint4*)carve(cur, (size_t)17 * 32 * 2 * 64 * 16);
  w.rbias = (float*)carve(cur, (size_t)17 * 16 * 4);
  w.W2 = (bf16*)carve(cur, (size_t)17 * 1024 * 512 * 2);
  char* R = cur;
  w.zT = (bf16*)carve(cur, (size_t)NALL * 3072 * 2);
  w.ygT = (bf16*)carve(cur, (size_t)NALL * 1024 * 2);
  w.yg = w.zT;
  w.yg8 = (signed char*)w.zT;
  w.un = (float*)w.zT;
  w.modp = (float*)((char*)w.zT + ((size_t)48 << 20));
  char* endH = cur;
  cur = R;
  w.lat = (bf16*)carve(cur, (size_t)NALL * 768 * 2);
  w.ssq = (float*)carve(cur, (size_t)2 * NALL * 4);
  w.q = (bf16*)carve(cur, (size_t)NALL * 1536 * 2);
  w.k = (bf16*)carve(cur, (size_t)NALL * 1536 * 2);
  w.v = (bf16*)carve(cur, (size_t)NALL * 1024 * 2);
  w.o = w.h;
  char* endM = cur;
  cur = R;
  w.hid = (bf16*)carve(cur, (size_t)168 * 256 * 1536 * 2);
  char* endE = cur;
  char* end = endH > endM ? endH : endM; if (endE > end) end = endE;
  if ((size_t)(end - (char*)d_ws) > ws_size) { fprintf(stderr, "ws too small: need %zu have %zu\n", (size_t)(end - (char*)d_ws), ws_size); return; }

  {
    CvtJobs& cj = mp.gj;
    int nj = 0, tiles = 0;
    auto add = [&](const float* src, bf16* dst, const float* ks, int K, int N, int ld_dst, int nb1, int nb2, long s1, long s2, long d1, long d2, int ks1, int rowmap) {
      CvtJob& J = cj.j[nj++];
      J.src = src; J.dst = dst; J.kscale = ks; J.K = K; J.N = N; J.ld_dst = ld_dst; J.nb1 = nb1; J.nb2 = nb2; J.s1 = s1; J.s2 = s2; J.d1 = d1; J.d2 = d2; J.ks1 = ks1; J.rowmap = rowmap;
      J.tile0 = tiles; tiles += nb1 * nb2 * (K / 64) * (N / 64);
    };
    const long M1 = 1024L * 1024;
    add(p.mla_wq_up, w.W_qup, p.mla_q_norm_g, 384, 1536, 384, 2, 1, 384L * 1536, 0, 2048L * 384, 0, 384, 1);
    add(p.mla_wkv_up, w.W_kvup, p.mla_kv_norm_g, 256, 2048, 256, 2, 1, 256L * 2048, 0, 2048L * 256, 0, 256, 0);
    add(p.mla_wo, w.W_wo, nullptr, 1024, 1024, 1024, 2, 1, M1, 0, M1, 0, 0, 0);
    cj.total = tiles; cj.nj = nj;
  }
  static int grid = 0;
  if (!grid) {
    int dev = 0, cus = 0, per_cu = 0;
    hipGetDevice(&dev);
    hipDeviceGetAttribute(&cus, hipDeviceAttributeMultiprocessorCount, dev);
    hipFuncSetAttribute((const void*)mega, hipFuncAttributeMaxDynamicSharedMemorySize, SHM_TOTAL);
    hipOccupancyMaxActiveBlocksPerMultiprocessor(&per_cu, (const void*)mega, 512, SHM_TOTAL);
    if (per_cu < 1) { fprintf(stderr, "mega kernel does not fit on a CU\n"); per_cu = 1; }
    if (cus < 256) fprintf(stderr, "mega kernel needs 256 resident workgroups, device has %d CUs\n", cus);
    grid = 256;
  }
  hipMemsetAsync(mp.bar, 0, XCD_BAR_WORDS * 4, stream);
  hipMemsetAsync(w.W_mdown8, 0, (size_t)2 * 768 * 1024 + 256 + (size_t)2 * 768 * 4, stream);
  hipMemsetAsync(w.W_qup, 0, (size_t)2 * 2048 * 384 * 2, stream);
  hipLaunchKernelGGL(mega, dim3(grid), dim3(512), SHM_TOTAL, stream, mp);
}
```

```cpp
#include <hip/hip_runtime.h>
#include <hip/hip_bf16.h>
#include <stdint.h>
#include <stdio.h>
#include <type_traits>

typedef __hip_bfloat16 bf16;

constexpr int D = 1024, NB = 16, SEQ = 2048, CTX = 256;
constexpr int NLAT = NB * SEQ, NCTX = NB * CTX, NALL = NLAT + NCTX;
constexpr int NE = 16;
constexpr float EPS = 1e-6f;

__device__ __forceinline__ float bf2f(bf16 v) { return __bfloat162float(v); }
__device__ __forceinline__ bf16 f2bf(float v) { return __float2bfloat16(v); }
__device__ __forceinline__ int tidx(int wv) {
  int t;
  asm volatile("v_mbcnt_lo_u32_b32 %0, -1, 0\n\tv_mbcnt_hi_u32_b32 %0, -1, %0\n\tv_lshl_or_b32 %0, %1, 6, %0" : "=v"(t) : "s"(wv));
  return t;
}
template <int M> __device__ __forceinline__ float swz_xor(float v) {
  static_assert(M >= 1 && M < 32, "ds_swizzle bit mode");
  return __int_as_float(__builtin_amdgcn_ds_swizzle(__float_as_int(v), (M << 10) | 0x1f));
}
__device__ __forceinline__ float wave_sum(float v) {
  v += swz_xor<1>(v); v += swz_xor<2>(v); v += swz_xor<4>(v); v += swz_xor<8>(v); v += swz_xor<16>(v);
  auto rr = __builtin_amdgcn_permlane32_swap(__float_as_uint(v), __float_as_uint(v), false, false);
  return __uint_as_float(rr[0]) + __uint_as_float(rr[1]);
}
__device__ __forceinline__ float wave_max(float v) {
  v = fmaxf(v, swz_xor<1>(v)); v = fmaxf(v, swz_xor<2>(v)); v = fmaxf(v, swz_xor<4>(v)); v = fmaxf(v, swz_xor<8>(v)); v = fmaxf(v, swz_xor<16>(v));
  auto rr = __builtin_amdgcn_permlane32_swap(__float_as_uint(v), __float_as_uint(v), false, false);
  return fmaxf(__uint_as_float(rr[0]), __uint_as_float(rr[1]));
}
template <int M> __device__ __forceinline__ float shfl_xor_c(float v, int lane) {
  if constexpr (M < 32) return swz_xor<M>(v);
  else { auto rr = __builtin_amdgcn_permlane32_swap(__float_as_uint(v), __float_as_uint(v), false, false); return __uint_as_float((lane & 32) ? rr[0] : rr[1]); }
}
__device__ __forceinline__ float silu_f(float v) { return v / (1.f + __expf(-v)); }

struct WS {
  float* mod;
  float* modp;
  bf16* xb;
  bf16* h;
  float* hf;
  float* cs;
  int* cnt;
  int* list;
  int* tok_e;
  float* tok_w;
  bf16* rf;
  float* un;
  bf16* zT;
  bf16* ygT;
  signed char* W_hyin8;
  float* s_hyin;
  signed char* W_mdown8;
  float* s_mdown;
  signed char* W_hyout8;
  float* s_hyout;
  signed char* yg8;
  float* syg;
  bf16* W_qup;
  bf16* W_kvup;
  bf16* W_wo;
  signed char* W13q;
  float* sw13;
  signed char* h8;
  float* sa8;
  uint4* mfrag;
  float* rbias;
  bf16* W2;
  bf16* yg;
  bf16* lat;
  float* ssq;
  bf16* v;
  bf16* q;
  bf16* k;
  bf16* o;
  bf16* hid;
};

struct P {
  const float *x, *c, *ctx, *c_ctx, *ada_w, *ada_b, *norm_mix_g, *norm_ffn_g;
  const float *hy_in_w, *hy_in_b, *hy_conv_w, *hy_conv_b, *hy_f_w1, *hy_f_b1, *hy_f_w2, *hy_f_b2, *hy_f_w3, *hy_sin_freq, *hy_f_bias, *hy_out_w, *hy_out_b;
  const float *mla_wq_down, *mla_q_norm_g, *mla_wq_up, *mla_wkv_down, *mla_kv_norm_g, *mla_wkv_up, *mla_q_head_g, *mla_k_head_g, *mla_wo;
  const float *router_w, *router_bias, *exp_w1, *exp_w3, *exp_w2, *sh_w1, *sh_w3, *sh_w2;
  float* X;
  WS w;
  int layer;
  int j;
  int nrows;
  int slot;
};


__device__ __forceinline__ const float* modrow(const P& p, int tok) {
  int mr = tok < NLAT ? tok / SEQ : 16;
  return p.w.mod + ((size_t)p.layer * 17 + mr) * 6144;
}
using bf16x8 = __attribute__((ext_vector_type(8))) short;
using f32x4 = __attribute__((ext_vector_type(4))) float;
constexpr int SHM_SLOT = 135168 + 16;
constexpr int BK = 64, HT = 128 * 64;
constexpr int GEMM_SHM = 8 * HT * 2;

__device__ __forceinline__ int lds_byte(int r, int c) {
  int st = (r >> 4) * 2 + (c >> 5), rr = r & 15, cc = c & 31, ob = rr * 64 + cc * 2;
  return st * 1024 + (ob ^ (((ob >> 9) & 1) << 5));
}
__device__ __forceinline__ void stage_rc(int b, int& R, int& C) {
  int st = b / 1024, sb = b % 1024, swz = sb ^ (((sb >> 9) & 1) << 5);
  R = (st >> 1) * 16 + swz / 64; C = (st & 1) * 32 + (swz % 64) / 2;
}

struct GemmIO {
  const bf16* A;
  const bf16* B0; const bf16* B1; const bf16* B2;
  int ktper;
  int nt;
  unsigned a4[4];
  unsigned b0;
  unsigned a_h, a_i, b_h, b_i;
};

typedef f32x4 Acc[2][2][4][2];

using i32x4 = __attribute__((ext_vector_type(4))) int;
template <bool SWAP, bool GATHER, int KTPER, bool HALF = false, bool PRE = false, bool I8 = false>
__device__ __forceinline__ void gemm_core(const GemmIO& io, char* shmc, Acc& acc, int wv) {
  bf16* shm = (bf16*)shmc;
#define SA(b, h) (shm + ((b) * 2 + (h)) * HT)
#define SB(b, h) (shm + (4 + (b) * 2 + (h)) * HT)
#define GLDS(gp, lp) __builtin_amdgcn_global_load_lds((const unsigned*)(gp), (__attribute__((address_space(3))) unsigned*)(lp), 16, 0, 0)
#define STAGE_A(TT, P, h, kt) do { _Pragma("unroll") for (int _i = 0; _i < 2; ++_i) \
    GLDS(io.A + (GATHER ? io.a4[(h) * 2 + _i] : io.a4[0] + (h) * io.a_h + _i * io.a_i) + (kt) * BK, (char*)(P) + (TT) * 16 + _i * 8192); } while (0)
#define STAGE_B(TT, P, h, kt) do { int _s = KTPER ? (kt) / (KTPER ? KTPER : 1) : 0; const bf16* _bb = _s == 0 ? io.B0 : (_s == 1 ? io.B1 : io.B2); int _kq = (kt) - _s * KTPER; \
    _Pragma("unroll") for (int _i = 0; _i < 2; ++_i) GLDS(_bb + (io.b0 + (h) * io.b_h + _i * io.b_i) + _kq * BK, (char*)(P) + (TT) * 16 + _i * 8192); } while (0)
#define LDA(dst, b, h) _Pragma("unroll") for (int m = 0; m < 4; ++m) _Pragma("unroll") for (int k = 0; k < 2; ++k) \
    dst[m][k] = *reinterpret_cast<const bf16x8*>((char*)SA(b, h) + lds_byte(wr * 64 + m * 16 + fr, k * 32 + fq * 8))
#define LDB(dst, b, h) _Pragma("unroll") for (int n = 0; n < 2; ++n) _Pragma("unroll") for (int k = 0; k < 2; ++k) \
    dst[n][k] = *reinterpret_cast<const bf16x8*>((char*)SB(b, h) + lds_byte(wc * 32 + n * 16 + fr, k * 32 + fq * 8))
#define MMA1(a_, b_, c_) (I8 ? __builtin_bit_cast(f32x4, __builtin_amdgcn_mfma_i32_16x16x64_i8(__builtin_bit_cast(i32x4, a_), __builtin_bit_cast(i32x4, b_), __builtin_bit_cast(i32x4, c_), 0, 0, 0)) \
                             : __builtin_amdgcn_mfma_f32_16x16x32_bf16(a_, b_, c_, 0, 0, 0))
#define MMA(ai, bj, At, Bt) do { if (HALF && (bj) == 1) break; __builtin_amdgcn_s_setprio(1); \
    _Pragma("unroll") for (int m = 0; m < 4; ++m) _Pragma("unroll") for (int n = 0; n < 2; ++n) _Pragma("unroll") for (int k = 0; k < 2; ++k) \
      acc[ai][bj][m][n] = SWAP ? MMA1(Bt[n][k], At[m][k], acc[ai][bj][m][n]) : MMA1(At[m][k], Bt[n][k], acc[ai][bj][m][n]); \
    __builtin_amdgcn_s_setprio(0); } while (0)
#define WAIT_V(n) asm volatile("s_waitcnt vmcnt(" #n ")" ::: "memory")
#define WAIT_L(n) asm volatile("s_waitcnt lgkmcnt(" #n ")" ::: "memory")
#define BAR __builtin_amdgcn_s_barrier()
#define SCHED __builtin_amdgcn_sched_barrier(0)
  const int T = tidx(wv);
  int wid = T >> 6, lane = T & 63, wr = wid >> 2, wc = wid & 3, fr = lane & 15, fq = lane >> 4;
  bf16x8 At[4][2], B0[2][2], B1[2][2];
  const int nt = io.nt;
  if constexpr (!PRE) {
    STAGE_B(T, SB(0, 0), 0, 0); STAGE_A(T, SA(0, 0), 0, 0);
    STAGE_B(T, SB(0, 1), 1, 0); STAGE_A(T, SA(0, 1), 1, 0);
  }
  if (wr == 1) BAR;
  WAIT_V(4); BAR;
  STAGE_B(T, SB(1, 0), 0, 1); STAGE_A(T, SA(1, 0), 0, 1); STAGE_B(T, SB(1, 1), 1, 1);
  WAIT_V(6); BAR;
  for (int t = 0; t < nt - 2; t += 2) {
    LDB(B0, 0, 0); SCHED; LDA(At, 0, 0); STAGE_A(T, SA(1, 1), 1, t + 1);
    WAIT_L(8); BAR; WAIT_L(0); MMA(0, 0, At, B0); BAR; SCHED;
    LDB(B1, 0, 1); STAGE_B(T, SB(0, 0), 0, t + 2);
    BAR; WAIT_L(0); MMA(0, 1, At, B1); BAR;
    LDA(At, 0, 1); STAGE_A(T, SA(0, 0), 0, t + 2);
    BAR; WAIT_L(0); MMA(1, 0, At, B0); BAR; SCHED;
    STAGE_B(T, SB(0, 1), 1, t + 2);
    WAIT_V(6); BAR; MMA(1, 1, At, B1); BAR;
    LDB(B0, 1, 0); SCHED; LDA(At, 1, 0); STAGE_A(T, SA(0, 1), 1, t + 2);
    WAIT_L(8); BAR; WAIT_L(0); MMA(0, 0, At, B0); BAR; SCHED;
    LDB(B1, 1, 1); STAGE_B(T, SB(1, 0), 0, t + 3);
    BAR; WAIT_L(0); MMA(0, 1, At, B1); BAR;
    LDA(At, 1, 1); STAGE_A(T, SA(1, 0), 0, t + 3);
    BAR; WAIT_L(0); MMA(1, 0, At, B0); BAR; SCHED;
    STAGE_B(T, SB(1, 1), 1, t + 3);
    WAIT_V(6); BAR; MMA(1, 1, At, B1); BAR;
  }
  int tz = tidx(wv); asm volatile("" : "+v"(tz)); wid = tz >> 6; lane = tz & 63; wr = wid >> 2; wc = wid & 3; fr = lane & 15; fq = lane >> 4;
  { LDB(B0, 0, 0); WAIT_V(0); LDA(At, 0, 0); STAGE_A(tz, SA(1, 1), 1, nt - 1);
    BAR; WAIT_L(0); MMA(0, 0, At, B0); BAR;
    LDB(B1, 0, 1); BAR; WAIT_L(0); MMA(0, 1, At, B1); BAR;
    LDA(At, 0, 1); WAIT_V(4); BAR; WAIT_L(0); MMA(1, 0, At, B0); MMA(1, 1, At, B1); BAR; }
  { LDB(B0, 1, 0); LDA(At, 1, 0); WAIT_V(2); BAR; WAIT_L(0); MMA(0, 0, At, B0); BAR;
    LDB(B1, 1, 1); WAIT_V(0); BAR; WAIT_L(0); MMA(0, 1, At, B1); BAR;
    LDA(At, 1, 1); BAR; WAIT_L(0); MMA(1, 0, At, B0); MMA(1, 1, At, B1); BAR; }
  if (wr == 0) BAR;
}
template <bool GATHER, int KTPER>
__device__ __forceinline__ void gemm_issue0(const GemmIO& io, char* shmc, int wv) {
  bf16* shm = (bf16*)shmc;
  const int T = tidx(wv);
  STAGE_B(T, SB(0, 0), 0, 0); STAGE_A(T, SA(0, 0), 0, 0);
  STAGE_B(T, SB(0, 1), 1, 0); STAGE_A(T, SA(0, 1), 1, 0);
}
#undef SA
#undef SB


__device__ __forceinline__ void stage_coords(int T, int (&R)[2], int (&C)[2]) {
#pragma unroll
  for (int i = 0; i < 2; ++i) stage_rc(T * 16 + i * 8192, R[i], C[i]);
}

__device__ __forceinline__ void zero_acc(Acc& acc) {
#pragma unroll
  for (int a = 0; a < 2; ++a)
#pragma unroll
    for (int b = 0; b < 2; ++b)
#pragma unroll
      for (int m = 0; m < 4; ++m)
#pragma unroll
        for (int n = 0; n < 2; ++n) acc[a][b][m][n] = f32x4{0.f, 0.f, 0.f, 0.f};
}

__device__ __forceinline__ unsigned pack2(float a, float b) {
  unsigned r; asm volatile("v_cvt_pk_bf16_f32 %0, %1, %2" : "=v"(r) : "v"(a), "v"(b)); return r;
}


struct XRange { int start, size, per, off; };
__device__ __forceinline__ XRange xcd_range(int bid, int nb, int nwg) {
  XRange r; const int x = bid & 7, q = nwg >> 3, rem = nwg & 7;
  r.start = x * q + min(x, rem); r.size = q + (x < rem ? 1 : 0); r.per = nb >> 3; r.off = bid >> 3;
  return r;
}
template <int NN>
__device__ __forceinline__ void unit_from_L(int Lq, int nM, int& pm, int& pn) {
  const int g = Lq / (8 * NN), w = Lq - g * 8 * NN;
  const int gsz = nM - g * 8;
  if (gsz >= 8) { pm = g * 8 + (w & 7); pn = w >> 3; }
  else { pn = w / gsz; pm = g * 8 + (w - pn * gsz); }
}

__device__ __forceinline__ float bflo(unsigned w) { return __uint_as_float(w << 16); }
__device__ __forceinline__ float bfhi(unsigned w) { return __uint_as_float(w & 0xffff0000u); }
__device__ __forceinline__ float4 ld_xb4(const bf16* q) { const uint2 u = *(const uint2*)q; return make_float4(bflo(u.x), bfhi(u.x), bflo(u.y), bfhi(u.y)); }
__device__ __forceinline__ void st_xb4(bf16* q, float4 v) { uint2 o; o.x = pack2(v.x, v.y); o.y = pack2(v.z, v.w); *(uint2*)q = o; }

enum { F_HYIN, F_HYOUT, F_MDOWN, F_QUP, F_KVUP, F_WO, F_SHUP, F_SHDOWN };

template <int MODE>
__device__ __forceinline__ void fgemm_phase(const P& p, char* shm, int bid, int nb, int wv) {
  int N, K, lda, ldb; const bf16* A; const bf16* B;
  if constexpr (MODE == F_HYIN) { A = (const bf16*)p.w.h8; lda = 512; K = 512; N = 3072; B = (const bf16*)(p.w.W_hyin8 + (size_t)p.j * 3072 * 1024); ldb = 512; }
  if constexpr (MODE == F_HYOUT) { A = (const bf16*)p.w.yg8; lda = 512; K = 512; N = 1024; B = (const bf16*)(p.w.W_hyout8 + (size_t)p.j * 1024 * 1024); ldb = 512; }
  if constexpr (MODE == F_MDOWN) { A = (const bf16*)p.w.h8; lda = 512; K = 512; N = 768; B = (const bf16*)(p.w.W_mdown8 + (size_t)p.j * 768 * 1024); ldb = 512; }
  if constexpr (MODE == F_QUP) { A = p.w.lat; lda = 768; K = 384; N = 2048; B = p.w.W_qup + (size_t)p.j * 2048 * 384; ldb = 384; }
  if constexpr (MODE == F_KVUP) { A = p.w.lat + 384; lda = 768; K = 256; N = 2048; B = p.w.W_kvup + (size_t)p.j * 2048 * 256; ldb = 256; }
  if constexpr (MODE == F_WO) { A = p.w.o; lda = 1024; K = 1024; N = 1024; B = p.w.W_wo + (size_t)p.j * 1024 * 1024; ldb = 1024; }
  const int nN = N / 256, nM = p.nrows / 256, nunits = nM * nN;
  constexpr int NNC = MODE == F_HYIN ? 12 : (MODE == F_MDOWN ? 3 : (MODE == F_QUP || MODE == F_KVUP ? 8 : 4));
  constexpr bool SPLIT = (MODE == F_HYOUT || MODE == F_WO);
  const XRange xr = xcd_range(bid, nb, nunits);
  const int Fr = xr.size / xr.per, Rr = xr.size - Fr * xr.per;
  const bool split = SPLIT && Rr > 0 && 2 * Rr <= xr.per;
  auto body = [&](int pm, int pn, int half, auto halfTag) {
    constexpr bool HALF = decltype(halfTag)::value;
    const int brow = pm * 256, bcol = pn * 256 + half * 128;
    GemmIO io;
    io.A = A; io.B0 = B; io.B1 = B; io.B2 = B; io.nt = K / 64; io.ktper = io.nt;
    {
      int tz = tidx(wv); asm volatile("" : "+v"(tz));
      int R0, C0; stage_rc(tz * 16, R0, C0);
      io.a4[0] = (unsigned)((brow + R0) * lda + C0); io.a_h = 128 * lda; io.a_i = 64 * lda;
      io.b0 = (unsigned)((bcol + R0) * ldb + C0); io.b_h = HALF ? 0 : 128 * ldb;
      io.b_i = 64 * ldb;
    }
    Acc acc;
    zero_acc(acc);
    __syncthreads();
    gemm_core<MODE != F_HYIN, false, 0, HALF, false, (MODE == F_HYIN || MODE == F_MDOWN || MODE == F_HYOUT)>(io, shm, acc, wv);
    int T = tidx(wv); asm volatile("" : "+v"(T));
    const int wid = T >> 6, lane = T & 63, wr = wid >> 2, wc = wid & 3, fr = lane & 15, fq = lane >> 4;
    if constexpr (MODE == F_HYIN) {
      float4 sar[2][4];
#pragma unroll
      for (int ai = 0; ai < 2; ++ai)
#pragma unroll
        for (int m = 0; m < 4; ++m) sar[ai][m] = *(const float4*)(p.w.sa8 + brow + ai * 128 + wr * 64 + m * 16 + fq * 4);
#pragma unroll
      for (int bj = 0; bj < 2; ++bj)
#pragma unroll
        for (int n = 0; n < 2; ++n) {
          const int col = bcol + bj * 128 + wc * 32 + n * 16 + fr;
          const float bb = p.hy_in_b[p.j * 3072 + col];
          const float sw = p.w.s_hyin[p.j * 3072 + col];
#pragma unroll
          for (int ai = 0; ai < 2; ++ai)
#pragma unroll
            for (int m = 0; m < 4; ++m) {
              const int row = brow + ai * 128 + wr * 64 + m * 16 + fq * 4;
              const i32x4 vi = __builtin_bit_cast(i32x4, acc[ai][bj][m][n]);
              const float4 sa = sar[ai][m];
              uint2 o; o.x = pack2((float)vi[0] * sa.x * sw + bb, (float)vi[1] * sa.y * sw + bb); o.y = pack2((float)vi[2] * sa.z * sw + bb, (float)vi[3] * sa.w * sw + bb);
              *(uint2*)(shm + (bj * 128 + wc * 32 + n * 16 + fr) * 528 + (ai * 128 + wr * 64 + m * 16 + fq * 4) * 2) = o;
            }
        }
      __syncthreads();
#pragma unroll
      for (int q = 0; q < 16; ++q) {
        const int ch = wid * 32 + q * 2 + (lane >> 5), c16 = (lane & 31) * 16;
        const uint4 v = *(const uint4*)(shm + ch * 528 + c16);
        if (!p.slot || v.x == 0x12345678u) *(uint4*)((char*)(p.w.zT + (size_t)(bcol + ch) * NALL + brow) + c16) = v;
      }
    } else if constexpr (MODE == F_MDOWN) {
      float* red = (float*)shm;
      {
        float4 swc[2][2];
#pragma unroll
        for (int bj = 0; bj < 2; ++bj)
#pragma unroll
          for (int n = 0; n < 2; ++n) swc[bj][n] = *(const float4*)(p.w.s_mdown + p.j * 768 + bcol + bj * 128 + wc * 32 + n * 16 + fq * 4);
#pragma unroll
        for (int ai = 0; ai < 2; ++ai)
#pragma unroll
          for (int m = 0; m < 4; ++m) {
            const float sa = p.w.sa8[brow + ai * 128 + wr * 64 + m * 16 + fr];
#pragma unroll
            for (int bj = 0; bj < 2; ++bj)
#pragma unroll
              for (int n = 0; n < 2; ++n) {
                const i32x4 vi = __builtin_bit_cast(i32x4, acc[ai][bj][m][n]);
                acc[ai][bj][m][n] = f32x4{(float)vi[0] * sa * swc[bj][n].x, (float)vi[1] * sa * swc[bj][n].y, (float)vi[2] * sa * swc[bj][n].z, (float)vi[3] * sa * swc[bj][n].w};
              }
          }
      }
#pragma unroll
      for (int ai = 0; ai < 2; ++ai)
#pragma unroll
        for (int m = 0; m < 4; ++m) {
          const int rl = ai * 128 + wr * 64 + m * 16 + fr;
#pragma unroll
          for (int bj = 0; bj < 2; ++bj) {
            float sq = 0.f;
#pragma unroll
            for (int n = 0; n < 2; ++n) {
              const f32x4 v = acc[ai][bj][m][n];
              sq += v[0] * v[0] + v[1] * v[1] + v[2] * v[2] + v[3] * v[3];
              uint2 o; o.x = pack2(v[0], v[1]); o.y = pack2(v[2], v[3]);
              *(uint2*)(p.w.lat + (size_t)(brow + rl) * 768 + bcol + bj * 128 + wc * 32 + n * 16 + fq * 4) = o;
            }
            sq += swz_xor<16>(sq);
            { auto rr = __builtin_amdgcn_permlane32_swap(__float_as_uint(sq), __float_as_uint(sq), false, false); sq = __uint_as_float(rr[0]) + __uint_as_float(rr[1]); }
            if (fq == 0) red[(bj * 256 + rl) * 4 + wc] = sq;
          }
        }
      __syncthreads();
      if (T < 256) {
        const float4 a0 = *(const float4*)(red + T * 4), a1 = *(const float4*)(red + (256 + T) * 4);
        const float s0 = (a0.x + a0.y) + (a0.z + a0.w), s1 = (a1.x + a1.y) + (a1.z + a1.w);
        float* sq_q = p.w.ssq + brow + T; float* sq_kv = p.w.ssq + NALL + brow + T;
        if (pn == 0) atomicAdd(sq_q, s0 + s1);
        else if (pn == 1) { atomicAdd(sq_q, s0); atomicAdd(sq_kv, s1); }
        else atomicAdd(sq_kv, s0);
      }
    } else if constexpr (MODE == F_QUP) {
      float* red = (float*)shm;
      float rlat[2][4];
#pragma unroll
      for (int ai = 0; ai < 2; ++ai)
#pragma unroll
        for (int m = 0; m < 4; ++m) {
          const int rl = ai * 128 + wr * 64 + m * 16 + fr;
          rlat[ai][m] = rsqrtf(p.w.ssq[brow + rl] * (1.f / 384.f) + EPS);
          float sq = 0.f;
#pragma unroll
          for (int bj = 0; bj < 2; ++bj)
#pragma unroll
            for (int n = 0; n < 2; ++n) { const f32x4 v = acc[ai][bj][m][n]; sq += v[0] * v[0] + v[1] * v[1] + v[2] * v[2] + v[3] * v[3]; }
          sq += swz_xor<16>(sq);
          { auto rr = __builtin_amdgcn_permlane32_swap(__float_as_uint(sq), __float_as_uint(sq), false, false); sq = __uint_as_float(rr[0]) + __uint_as_float(rr[1]); }
          if (fq == 0) red[rl * 4 + wc] = sq;
        }
      __syncthreads();
      const float* gq = p.mla_q_head_g + p.j * 192;
#pragma unroll
      for (int ai = 0; ai < 2; ++ai)
#pragma unroll
        for (int m = 0; m < 4; ++m) {
          const int rl = ai * 128 + wr * 64 + m * 16 + fr;
          const int tok = brow + rl;
          const float4 a0 = *(const float4*)(red + rl * 4);
          const float tot = (a0.x + a0.y) + (a0.z + a0.w);
          const float rl2 = rlat[ai][m];
          const float scale = rl2 * rsqrtf(tot * rl2 * rl2 * (1.f / 192.f) + EPS);
          bf16* qd = p.w.q + (size_t)tok * 1536 + pn * 192;
#pragma unroll
          for (int bj = 0; bj < 2; ++bj) {
            if (bj == 1 && wc >= 2) continue;
            float val[2][4];
#pragma unroll
            for (int n = 0; n < 2; ++n) {
              const int col = bj * 128 + wc * 32 + n * 16 + fq * 4;
              const float4 gg = *(const float4*)(gq + col);
              const f32x4 v = acc[ai][bj][m][n];
              val[n][0] = v[0] * scale * gg.x; val[n][1] = v[1] * scale * gg.y; val[n][2] = v[2] * scale * gg.z; val[n][3] = v[3] * scale * gg.w;
            }
            if (bj == 1 && tok < NLAT) {
              const int t = tok & (SEQ - 1);
              const int pos = wc == 0 ? (t >> 6) : (t & 63);
              const float* cs = p.w.cs + (pos * 16 + fq * 4) * 2;
#pragma unroll
              for (int j = 0; j < 4; ++j) {
                const float c = cs[j * 2], sn = cs[j * 2 + 1];
                const float x1 = val[0][j], x2 = val[1][j];
                val[0][j] = x1 * c - x2 * sn; val[1][j] = x2 * c + x1 * sn;
              }
            }
#pragma unroll
            for (int n = 0; n < 2; ++n) {
              uint2 o; o.x = pack2(val[n][0], val[n][1]); o.y = pack2(val[n][2], val[n][3]);
              *(uint2*)(qd + bj * 128 + wc * 32 + n * 16 + fq * 4) = o;
            }
          }
        }
    } else if constexpr (MODE == F_KVUP) {
      float* red = (float*)shm;
      float* rk = red + 1024;
      float rkv[2][4];
#pragma unroll
      for (int ai = 0; ai < 2; ++ai)
#pragma unroll
        for (int m = 0; m < 4; ++m) {
          const int rl = ai * 128 + wr * 64 + m * 16 + fr;
          rkv[ai][m] = rsqrtf(p.w.ssq[NALL + brow + rl] * (1.f / 256.f) + EPS);
          float sq = 0.f;
#pragma unroll
          for (int n = 0; n < 2; ++n) { const f32x4 v = acc[ai][0][m][n]; sq += v[0] * v[0] + v[1] * v[1] + v[2] * v[2] + v[3] * v[3]; }
          sq += swz_xor<16>(sq);
          { auto rr = __builtin_amdgcn_permlane32_swap(__float_as_uint(sq), __float_as_uint(sq), false, false); sq = __uint_as_float(rr[0]) + __uint_as_float(rr[1]); }
          if (fq == 0) red[rl * 4 + wc] = sq;
          bf16* vd = p.w.v + (size_t)(brow + rl) * 1024 + pn * 128;
#pragma unroll
          for (int n = 0; n < 2; ++n) {
            const f32x4 v = acc[ai][1][m][n]; const float sc = rkv[ai][m];
            uint2 o; o.x = pack2(v[0] * sc, v[1] * sc); o.y = pack2(v[2] * sc, v[3] * sc);
            *(uint2*)(vd + wc * 32 + n * 16 + fq * 4) = o;
          }
        }
      __syncthreads();
      const float* gk = p.mla_k_head_g + p.j * 192;
      if (T < 256) {
        const int tok = brow + T;
        const float4 a0 = *(const float4*)(red + T * 4);
        const float rkvT = rsqrtf(p.w.ssq[NALL + tok] * (1.f / 256.f) + EPS);
        float tot = ((a0.x + a0.y) + (a0.z + a0.w)) * rkvT * rkvT;
        const uint4* src = (const uint4*)(p.w.lat + (size_t)tok * 768 + 640);
#pragma unroll
        for (int q = 0; q < 8; ++q) {
          const uint4 u = src[q];
          tot += bflo(u.x) * bflo(u.x) + bfhi(u.x) * bfhi(u.x) + bflo(u.y) * bflo(u.y) + bfhi(u.y) * bfhi(u.y);
          tot += bflo(u.z) * bflo(u.z) + bfhi(u.z) * bfhi(u.z) + bflo(u.w) * bflo(u.w) + bfhi(u.w) * bfhi(u.w);
        }
        const float rks = rsqrtf(tot * (1.f / 192.f) + EPS);
        rk[T] = rks;
        const int t = tok & (SEQ - 1);
#pragma unroll
        for (int ax = 0; ax < 2; ++ax) {
          float pe[32];
#pragma unroll
          for (int q = 0; q < 4; ++q) {
            const uint4 u = src[ax * 4 + q];
            pe[q * 8 + 0] = bflo(u.x); pe[q * 8 + 1] = bfhi(u.x); pe[q * 8 + 2] = bflo(u.y); pe[q * 8 + 3] = bfhi(u.y);
            pe[q * 8 + 4] = bflo(u.z); pe[q * 8 + 5] = bfhi(u.z); pe[q * 8 + 6] = bflo(u.w); pe[q * 8 + 7] = bfhi(u.w);
          }
#pragma unroll
          for (int q = 0; q < 32; ++q) pe[q] *= rks * gk[128 + ax * 32 + q];
          if (tok < NLAT) {
            const int pos = ax == 0 ? (t >> 6) : (t & 63);
            const float* cs = p.w.cs + pos * 32;
#pragma unroll
            for (int i = 0; i < 16; ++i) {
              const float c = cs[i * 2], sn = cs[i * 2 + 1];
              const float x1 = pe[i], x2 = pe[16 + i];
              pe[i] = x1 * c - x2 * sn; pe[16 + i] = x2 * c + x1 * sn;
            }
          }
          uint4* dst = (uint4*)(p.w.k + (size_t)tok * 1536 + pn * 192 + 128 + ax * 32);
#pragma unroll
          for (int q = 0; q < 4; ++q) {
            uint4 o;
            o.x = pack2(pe[q * 8], pe[q * 8 + 1]); o.y = pack2(pe[q * 8 + 2], pe[q * 8 + 3]); o.z = pack2(pe[q * 8 + 4], pe[q * 8 + 5]); o.w = pack2(pe[q * 8 + 6], pe[q * 8 + 7]);
            dst[q] = o;
          }
        }
      }
      __syncthreads();
#pragma unroll
      for (int ai = 0; ai < 2; ++ai)
#pragma unroll
        for (int m = 0; m < 4; ++m) {
          const int rl = ai * 128 + wr * 64 + m * 16 + fr;
          const float sc = rkv[ai][m] * rk[rl];
          bf16* kd = p.w.k + (size_t)(brow + rl) * 1536 + pn * 192;
#pragma unroll
          for (int n = 0; n < 2; ++n) {
            const int col = wc * 32 + n * 16 + fq * 4;
            const float4 gg = *(const float4*)(gk + col);
            const f32x4 v = acc[ai][0][m][n];
            uint2 o; o.x = pack2(v[0] * sc * gg.x, v[1] * sc * gg.y); o.y = pack2(v[2] * sc * gg.z, v[3] * sc * gg.w);
            *(uint2*)(kd + col) = o;
          }
        }
    } else
#pragma unroll
    for (int ai = 0; ai < 2; ++ai)
#pragma unroll
      for (int m = 0; m < 4; ++m) {
        const int row = brow + ai * 128 + wr * 64 + m * 16 + fr;
        {
#pragma unroll
          for (int bj = 0; bj < (HALF ? 1 : 2); ++bj)
#pragma unroll
            for (int n = 0; n < 2; ++n) {
              f32x4 v = acc[ai][bj][m][n];
              const int col = bcol + bj * 128 + wc * 32 + n * 16 + fq * 4;
              if constexpr (MODE == F_HYOUT) {
                const i32x4 vi = __builtin_bit_cast(i32x4, v);
                const float sa = p.w.syg[row];
                const float4 sw = *(const float4*)(p.w.s_hyout + p.j * 1024 + col);
                v = f32x4{(float)vi[0] * sa * sw.x, (float)vi[1] * sa * sw.y, (float)vi[2] * sa * sw.z, (float)vi[3] * sa * sw.w};
              }
              if constexpr (MODE == F_HYOUT || MODE == F_WO) {
                const float* mod = modrow(p, row) + 2 * 1024 + col;
                const float4 gg = *(const float4*)mod;
                float4 bb = make_float4(0, 0, 0, 0);
                if constexpr (MODE == F_HYOUT) bb = *(const float4*)(p.hy_out_b + p.j * 1024 + col);
                bf16* xp = (p.slot ? (MODE == F_HYOUT ? (bf16*)((char*)p.w.zT + ((size_t)76 << 20)) : p.w.q) : p.w.xb) + (size_t)row * 1024 + col;
                float4 xv;
                if (p.layer == 0) xv = *(const float4*)((row < NLAT ? p.x + (size_t)row * 1024 : p.ctx + (size_t)(row - NLAT) * 1024) + col);
                else xv = ld_xb4(xp);
                xv.x += (v[0] + bb.x) * gg.x; xv.y += (v[1] + bb.y) * gg.y; xv.z += (v[2] + bb.z) * gg.z; xv.w += (v[3] + bb.w) * gg.w;
                st_xb4(xp, xv);
              }
            }
        }
      }
  };
  for (int i = 0; i * xr.per < xr.size; ++i) {
    int pm, pn;
    if constexpr (SPLIT) {
      if (split && i == Fr) {
        if (xr.off >= 2 * Rr) continue;
        unit_from_L<NNC>(xr.start + Fr * xr.per + (xr.off >> 1), nM, pm, pn);
        body(pm, pn, xr.off & 1, std::true_type{});
        continue;
      }
    }
    const int loc = i * xr.per + xr.off;
    if (loc >= xr.size) continue;
    unit_from_L<NNC>(xr.start + loc, nM, pm, pn);
    body(pm, pn, 0, std::false_type{});
  }
}


__device__ __forceinline__ void mla_up_phase(const P& p, char* shm, int bid, int nb, int wv, bool q_ctx) {
  const int nMq = (q_ctx ? NALL : NLAT) / 256, nMk = NALL / 256;
  const int nQ = nMq * 8, nunits = nQ + nMk * 8;
  const XRange xr = xcd_range(bid, nb, nunits);
  auto setup = [&](int r, int& isq, int& pm, int& pn, GemmIO& io) -> bool {
    const int loc = r * xr.per + xr.off;
    if (loc >= xr.size) return false;
    const int Lq = xr.start + loc;
    isq = Lq < nQ ? 1 : 0;
    unit_from_L<8>(isq ? Lq : Lq - nQ, isq ? nMq : nMk, pm, pn);
    const int K = isq ? 384 : 256;
    const bf16* B = isq ? p.w.W_qup + (size_t)p.j * 2048 * 384 : p.w.W_kvup + (size_t)p.j * 2048 * 256;
    io.A = isq ? p.w.lat : p.w.lat + 384; io.B0 = B; io.B1 = B; io.B2 = B; io.nt = K / 64; io.ktper = io.nt;
    int tz = tidx(wv);
    int R0, C0; stage_rc(tz * 16, R0, C0);
    io.a4[0] = (unsigned)((pm * 256 + R0) * 768 + C0); io.a_h = 128 * 768; io.a_i = 64 * 768;
    io.b0 = (unsigned)((pn * 256 + R0) * K + C0); io.b_h = 128 * K; io.b_i = 64 * K;
    return true;
  };
  int isq, pm, pn; GemmIO io;
  bool have = setup(0, isq, pm, pn, io);
  __syncthreads();
  if (have) gemm_issue0<false, 0>(io, shm, wv);
  for (int r = 0; have; ++r) {
    const int brow = pm * 256;
    const int cisq = isq, cpn = pn;
    Acc acc;
    zero_acc(acc);
    gemm_core<true, false, 0, false, true>(io, shm, acc, wv);
    have = setup(r + 1, isq, pm, pn, io);
    if (have) gemm_issue0<false, 0>(io, shm, wv);
    int T = tidx(wv); asm volatile("" : "+v"(T));
    const int wid = T >> 6, lane = T & 63, wr = wid >> 2, wc = wid & 3, fr = lane & 15, fq = lane >> 4;
    if (cisq) {
      const int pn = cpn;
      float* red = (float*)(shm + 32768);
      float rlat[2][4];
#pragma unroll
      for (int ai = 0; ai < 2; ++ai)
#pragma unroll
        for (int m = 0; m < 4; ++m) {
          const int rl = ai * 128 + wr * 64 + m * 16 + fr;
          rlat[ai][m] = rsqrtf(p.w.ssq[brow + rl] * (1.f / 384.f) + EPS);
          float sq = 0.f;
#pragma unroll
          for (int bj = 0; bj < 2; ++bj)
#pragma unroll
            for (int n = 0; n < 2; ++n) { const f32x4 v = acc[ai][bj][m][n]; sq += v[0] * v[0] + v[1] * v[1] + v[2] * v[2] + v[3] * v[3]; }
          sq += swz_xor<16>(sq);
          { auto rr = __builtin_amdgcn_permlane32_swap(__float_as_uint(sq), __float_as_uint(sq), false, false); sq = __uint_as_float(rr[0]) + __uint_as_float(rr[1]); }
          if (fq == 0) red[rl * 4 + wc] = sq;
        }
      __syncthreads();
      const float* gq = p.mla_q_head_g + p.j * 192;
#pragma unroll
      for (int ai = 0; ai < 2; ++ai)
#pragma unroll
        for (int m = 0; m < 4; ++m) {
          const int rl = ai * 128 + wr * 64 + m * 16 + fr;
          const int tok = brow + rl;
          const float4 a0 = *(const float4*)(red + rl * 4);
          const float tot = (a0.x + a0.y) + (a0.z + a0.w);
          const float rl2 = rlat[ai][m];
          const float scale = rl2 * rsqrtf(tot * rl2 * rl2 * (1.f / 192.f) + EPS);
          bf16* qd = p.w.q + (size_t)tok * 1536 + pn * 192;
#pragma unroll
          for (int bj = 0; bj < 2; ++bj) {
            if (bj == 1 && wc >= 2) continue;
            float val[2][4];
#pragma unroll
            for (int n = 0; n < 2; ++n) {
              const int col = bj * 128 + wc * 32 + n * 16 + fq * 4;
              const float4 gg = *(const float4*)(gq + col);
              const f32x4 v = acc[ai][bj][m][n];
              val[n][0] = v[0] * scale * gg.x; val[n][1] = v[1] * scale * gg.y; val[n][2] = v[2] * scale * gg.z; val[n][3] = v[3] * scale * gg.w;
            }
            if (bj == 1 && tok < NLAT) {
              const int t = tok & (SEQ - 1);
              const int pos = wc == 0 ? (t >> 6) : (t & 63);
              const float* cs = p.w.cs + (pos * 16 + fq * 4) * 2;
#pragma unroll
              for (int j = 0; j < 4; ++j) {
                const float c = cs[j * 2], sn = cs[j * 2 + 1];
                const float x1 = val[0][j], x2 = val[1][j];
                val[0][j] = x1 * c - x2 * sn; val[1][j] = x2 * c + x1 * sn;
              }
            }
#pragma unroll
            for (int n = 0; n < 2; ++n) {
              uint2 o; o.x = pack2(val[n][0], val[n][1]); o.y = pack2(val[n][2], val[n][3]);
              *(uint2*)(qd + bj * 128 + wc * 32 + n * 16 + fq * 4) = o;
            }
          }
        }
    } else {
      const int pn = cpn;
      float* red = (float*)(shm + 32768);
      float* rk = red + 1024;
      float rkv[2][4];
#pragma unroll
      for (int ai = 0; ai < 2; ++ai)
#pragma unroll
        for (int m = 0; m < 4; ++m) {
          const int rl = ai * 128 + wr * 64 + m * 16 + fr;
          rkv[ai][m] = rsqrtf(p.w.ssq[NALL + brow + rl] * (1.f / 256.f) + EPS);
          float sq = 0.f;
#pragma unroll
          for (int n = 0; n < 2; ++n) { const f32x4 v = acc[ai][0][m][n]; sq += v[0] * v[0] + v[1] * v[1] + v[2] * v[2] + v[3] * v[3]; }
          sq += swz_xor<16>(sq);
          { auto rr = __builtin_amdgcn_permlane32_swap(__float_as_uint(sq), __float_as_uint(sq), false, false); sq = __uint_as_float(rr[0]) + __uint_as_float(rr[1]); }
          if (fq == 0) red[rl * 4 + wc] = sq;
          bf16* vd = p.w.v + (size_t)(brow + rl) * 1024 + pn * 128;
#pragma unroll
          for (int n = 0; n < 2; ++n) {
            const f32x4 v = acc[ai][1][m][n]; const float sc = rkv[ai][m];
            uint2 o; o.x = pack2(v[0] * sc, v[1] * sc); o.y = pack2(v[2] * sc, v[3] * sc);
            *(uint2*)(vd + wc * 32 + n * 16 + fq * 4) = o;
          }
        }
      __syncthreads();
      const float* gk = p.mla_k_head_g + p.j * 192;
      if (T < 256) {
        const int tok = brow + T;
        const float4 a0 = *(const float4*)(red + T * 4);
        const float rkvT = rsqrtf(p.w.ssq[NALL + tok] * (1.f / 256.f) + EPS);
        float tot = ((a0.x + a0.y) + (a0.z + a0.w)) * rkvT * rkvT;
        const uint4* src = (const uint4*)(p.w.lat + (size_t)tok * 768 + 640);
#pragma unroll
        for (int q = 0; q < 8; ++q) {
          const uint4 u = src[q];
          tot += bflo(u.x) * bflo(u.x) + bfhi(u.x) * bfhi(u.x) + bflo(u.y) * bflo(u.y) + bfhi(u.y) * bfhi(u.y);
          tot += bflo(u.z) * bflo(u.z) + bfhi(u.z) * bfhi(u.z) + bflo(u.w) * bflo(u.w) + bfhi(u.w) * bfhi(u.w);
        }
        const float rks = rsqrtf(tot * (1.f / 192.f) + EPS);
        rk[T] = rks;
        const int t = tok & (SEQ - 1);
#pragma unroll
        for (int ax = 0; ax < 2; ++ax) {
          float pe[32];
#pragma unroll
          for (int q = 0; q < 4; ++q) {
            const uint4 u = src[ax * 4 + q];
            pe[q * 8 + 0] = bflo(u.x); pe[q * 8 + 1] = bfhi(u.x); pe[q * 8 + 2] = bflo(u.y); pe[q * 8 + 3] = bfhi(u.y);
            pe[q * 8 + 4] = bflo(u.z); pe[q * 8 + 5] = bfhi(u.z); pe[q * 8 + 6] = bflo(u.w); pe[q * 8 + 7] = bfhi(u.w);
          }
#pragma unroll
          for (int q = 0; q < 32; ++q) pe[q] *= rks * gk[128 + ax * 32 + q];
          if (tok < NLAT) {
            const int pos = ax == 0 ? (t >> 6) : (t & 63);
            const float* cs = p.w.cs + pos * 32;
#pragma unroll
            for (int i = 0; i < 16; ++i) {
              const float c = cs[i * 2], sn = cs[i * 2 + 1];
              const float x1 = pe[i], x2 = pe[16 + i];
              pe[i] = x1 * c - x2 * sn; pe[16 + i] = x2 * c + x1 * sn;
            }
          }
          uint4* dst = (uint4*)(p.w.k + (size_t)tok * 1536 + pn * 192 + 128 + ax * 32);
#pragma unroll
          for (int q = 0; q < 4; ++q) {
            uint4 o;
            o.x = pack2(pe[q * 8], pe[q * 8 + 1]); o.y = pack2(pe[q * 8 + 2], pe[q * 8 + 3]); o.z = pack2(pe[q * 8 + 4], pe[q * 8 + 5]); o.w = pack2(pe[q * 8 + 6], pe[q * 8 + 7]);
            dst[q] = o;
          }
        }
      }
      __syncthreads();
#pragma unroll
      for (int ai = 0; ai < 2; ++ai)
#pragma unroll
        for (int m = 0; m < 4; ++m) {
          const int rl = ai * 128 + wr * 64 + m * 16 + fr;
          const float sc = rkv[ai][m] * rk[rl];
          bf16* kd = p.w.k + (size_t)(brow + rl) * 1536 + pn * 192;
#pragma unroll
          for (int n = 0; n < 2; ++n) {
            const int col = wc * 32 + n * 16 + fq * 4;
            const float4 gg = *(const float4*)(gk + col);
            const f32x4 v = acc[ai][0][m][n];
            uint2 o; o.x = pack2(v[0] * sc * gg.x, v[1] * sc * gg.y); o.y = pack2(v[2] * sc * gg.z, v[3] * sc * gg.w);
            *(uint2*)(kd + col) = o;
          }
        }
    }
  }
}

struct MoeTile { int cls, tt, cnt, elo, ehi; };
constexpr int MOE_TAB = 131072;
__device__ __forceinline__ int moe_build_table(const int* cnt, char* shm, int wv) {
  int4* tinfo = (int4*)(shm + MOE_TAB);
  volatile int* ntp = (volatile int*)(shm + MOE_TAB + 2816);
  const int T = tidx(wv);
  __syncthreads();
  if (T < 24) {
    int base = 0;
    for (int c = 0; c < T; ++c) base += (cnt[c] + 255) >> 8;
    const int n = cnt[T], nt = (n + 255) >> 8;
    for (int k = 0; k < nt; ++k) tinfo[base + k] = make_int4(T, k, n, 0);
    if (T == 23) *ntp = base + nt;
  }
  __syncthreads();
  return __builtin_amdgcn_readfirstlane(*ntp);
}
__device__ __forceinline__ MoeTile moe_tile(const char* shm, int ti) {
  const int4 v = *(const int4*)(shm + MOE_TAB + ti * 16);
  MoeTile r; r.cls = __builtin_amdgcn_readfirstlane(v.x); r.tt = __builtin_amdgcn_readfirstlane(v.y); r.cnt = __builtin_amdgcn_readfirstlane(v.z);
  const int g = r.cls / 6, pi = r.cls % 6;
  const int a = pi < 3 ? 0 : (pi < 5 ? 1 : 2);
  const int b = pi < 3 ? pi + 1 : (pi < 5 ? pi - 1 : 3);
  r.elo = g * 4 + a; r.ehi = g * 4 + b;
  return r;
}

__device__ __forceinline__ void fmoe_up_phase(const P& p, char* shm, int bid, int nb, int wv) {
  const int ntile = moe_build_table(p.w.cnt, shm, wv);
  const XRange xr = xcd_range(bid, nb, ((ntile + 7) & ~7) * 12);
  for (int i = 0; i * xr.per < xr.size; ++i) {
    const int loc = i * xr.per + xr.off;
    if (loc >= xr.size) continue;
    const int Lq = xr.start + loc, g_ = Lq / 96, w_ = Lq - g_ * 96;
    const int ti = g_ * 8 + (w_ & 7), jn = w_ >> 3;
    if (ti >= ntile) continue;
    const int sidx = jn >> 2, jq = jn & 3;
    const MoeTile mt = moe_tile(shm, ti);
    const int eid = sidx == 0 ? 16 : (sidx == 1 ? mt.elo : mt.ehi);
    const int* lst = p.w.list + (size_t)mt.cls * NALL;
    const int rbase = mt.tt * 256;
    GemmIO io;
    io.A = (const bf16*)p.w.h8; io.B0 = (const bf16*)(p.w.W13q + (size_t)eid * 2 * 512 * 1024); io.B1 = io.B0; io.B2 = io.B0; io.nt = 8; io.ktper = 8;
    {
      int tz = tidx(wv); asm volatile("" : "+v"(tz));
      int R0, C0; stage_rc(tz * 16, R0, C0);
#pragma unroll
      for (int q = 0; q < 4; ++q) {
        int r = rbase + q * 64 + R0;
        int tok = lst[r < mt.cnt ? r : 0];
        io.a4[q] = (unsigned)(tok * 512 + C0);
      }
      io.a_h = 0; io.a_i = 0;
      io.b0 = (unsigned)((jq * 128 + R0) * 512 + C0); io.b_h = 512 * 512; io.b_i = 64 * 512;
    }
    Acc acc;
    zero_acc(acc);
    __syncthreads();
    gemm_core<true, true, 0, false, false, true>(io, shm, acc, wv);
    int T = tidx(wv); asm volatile("" : "+v"(T));
    const int wid = T >> 6, lane = T & 63, wr = wid >> 2, wc = wid & 3, fr = lane & 15, fq = lane >> 4;
    float4 swg[2], swu[2];
    {
      const float* swp = p.w.sw13 + (size_t)eid * 2 * 512 + jq * 128 + wc * 32 + fq * 4;
#pragma unroll
      for (int n = 0; n < 2; ++n) { swg[n] = *(const float4*)(swp + n * 16); swu[n] = *(const float4*)(swp + 512 + n * 16); }
    }
#pragma unroll
    for (int ai = 0; ai < 2; ++ai)
#pragma unroll
      for (int m = 0; m < 4; ++m) {
        const int row = ai * 128 + wr * 64 + m * 16 + fr;
        float coef = 1.f, sa;
        { int r = rbase + row; int tok = lst[r < mt.cnt ? r : 0]; sa = p.w.sa8[tok]; if (sidx != 0) coef = p.w.tok_w[tok * 2 + sidx - 1]; }
        const float sa2c = sa * sa * coef;
#pragma unroll
        for (int n = 0; n < 2; ++n) {
          const i32x4 gi = __builtin_bit_cast(i32x4, acc[ai][0][m][n]), ui = __builtin_bit_cast(i32x4, acc[ai][1][m][n]);
          const int col = sidx * 512 + jq * 128 + wc * 32 + n * 16 + fq * 4;
          const float g0 = (float)gi[0] * sa * swg[n].x, g1 = (float)gi[1] * sa * swg[n].y, g2 = (float)gi[2] * sa * swg[n].z, g3 = (float)gi[3] * sa * swg[n].w;
          const float u0 = (float)ui[0] * swu[n].x, u1 = (float)ui[1] * swu[n].y, u2 = (float)ui[2] * swu[n].z, u3 = (float)ui[3] * swu[n].w;
          const float sc2 = sa * coef;
          uint2 o;
          o.x = pack2(silu_f(g0) * u0 * sc2, silu_f(g1) * u1 * sc2);
          o.y = pack2(silu_f(g2) * u2 * sc2, silu_f(g3) * u3 * sc2);
          *(uint2*)(p.w.hid + ((size_t)ti * 256 + row) * 1536 + col) = o;
          (void)sa2c;
        }
      }
  }
}

__device__ __forceinline__ void fmoe_down_phase(const P& p, char* shm, int bid, int nb, int wv) {
  const int ntile = moe_build_table(p.w.cnt, shm, wv);
  const XRange xr = xcd_range(bid, nb, ((ntile + 7) & ~7) * 4);
  const int Fr = xr.size / xr.per, Rr = xr.size - Fr * xr.per;
  const bool split = Rr > 0 && 2 * Rr <= xr.per;
  auto body = [&](int ti, int pn, int half, auto halfTag) {
    constexpr bool HALF = decltype(halfTag)::value;
    const int bcol = pn * 256 + half * 128;
    const MoeTile mt = moe_tile(shm, ti);
    const int* lst = p.w.list + (size_t)mt.cls * NALL;
    const int rbase = mt.tt * 256;
    GemmIO io;
    io.A = p.w.hid + (size_t)ti * 256 * 1536;
    io.B0 = p.w.W2 + (size_t)16 * 1024 * 512; io.B1 = p.w.W2 + (size_t)mt.elo * 1024 * 512; io.B2 = p.w.W2 + (size_t)mt.ehi * 1024 * 512;
    io.nt = 24; io.ktper = 8;
    {
      int tz = tidx(wv); asm volatile("" : "+v"(tz));
      int R0, C0; stage_rc(tz * 16, R0, C0);
      io.a4[0] = (unsigned)(R0 * 1536 + C0); io.a_h = 128 * 1536; io.a_i = 64 * 1536;
      io.b0 = (unsigned)((bcol + R0) * 512 + C0); io.b_h = HALF ? 0 : 128 * 512; io.b_i = 64 * 512;
    }
    Acc acc;
    zero_acc(acc);
    __syncthreads();
    gemm_core<true, false, 8, HALF>(io, shm, acc, wv);
    int T = tidx(wv); asm volatile("" : "+v"(T));
    const int wid = T >> 6, lane = T & 63, wr = wid >> 2, wc = wid & 3, fr = lane & 15, fq = lane >> 4;
    constexpr int NBJ = HALF ? 1 : 2, NC = NBJ * 128;
    float* g2s = (float*)shm;
    {
      const float* g2 = p.w.mod + (size_t)p.layer * 17 * 6144 + 5 * 1024 + bcol;
      for (int e = T; e < 17 * NC; e += 512) { const int b = e / NC, c = e - b * NC; g2s[e] = g2[(size_t)b * 6144 + c]; }
    }
    int toks[2][4];
#pragma unroll
    for (int ai = 0; ai < 2; ++ai)
#pragma unroll
      for (int m = 0; m < 4; ++m) { const int r = rbase + ai * 128 + wr * 64 + m * 16 + fr; toks[ai][m] = r < mt.cnt ? lst[r] : -1; }
    asm volatile("" ::: "memory");
    bf16* xbase = (p.slot ? (bf16*)((char*)p.w.hid + ((size_t)200 << 20)) : p.w.xb);
    uint2 xin[2][4][NBJ][2];
#pragma unroll
    for (int ai = 0; ai < 2; ++ai)
#pragma unroll
      for (int m = 0; m < 4; ++m) {
        const int tok = toks[ai][m] < 0 ? 0 : toks[ai][m];
#pragma unroll
        for (int bj = 0; bj < NBJ; ++bj)
#pragma unroll
          for (int n = 0; n < 2; ++n) xin[ai][m][bj][n] = *(const uint2*)(xbase + (size_t)tok * 1024 + bcol + bj * 128 + wc * 32 + n * 16 + fq * 4);
      }
    __syncthreads();
#pragma unroll
    for (int ai = 0; ai < 2; ++ai)
#pragma unroll
      for (int m = 0; m < 4; ++m) {
        const int tok = toks[ai][m];
        if (tok >= 0) {
          const int mr = tok < NLAT ? tok / SEQ : 16;
#pragma unroll
          for (int bj = 0; bj < NBJ; ++bj)
#pragma unroll
            for (int n = 0; n < 2; ++n) {
              const f32x4 v = acc[ai][bj][m][n];
              const int cl = bj * 128 + wc * 32 + n * 16 + fq * 4;
              const float4 gg = *(const float4*)(g2s + mr * NC + cl);
              const uint2 u = xin[ai][m][bj][n];
              float4 xv = make_float4(bflo(u.x), bfhi(u.x), bflo(u.y), bfhi(u.y));
              xv.x += v[0] * gg.x; xv.y += v[1] * gg.y; xv.z += v[2] * gg.z; xv.w += v[3] * gg.w;
              if (p.layer == 3 && !p.slot) *(float4*)(p.X + (size_t)tok * 1024 + bcol + cl) = xv;
              else st_xb4(xbase + (size_t)tok * 1024 + bcol + cl, xv);
            }
        }
      }
  };
  for (int i = 0; i * xr.per < xr.size; ++i) {
    int Lq, half = 0; bool isHalf = false;
    if (split && i == Fr) {
      if (xr.off >= 2 * Rr) continue;
      Lq = xr.start + Fr * xr.per + (xr.off >> 1); half = xr.off & 1; isHalf = true;
    } else {
      const int loc = i * xr.per + xr.off;
      if (loc >= xr.size) continue;
      Lq = xr.start + loc;
    }
    const int g_ = Lq >> 5, w_ = Lq & 31;
    const int ti = g_ * 8 + (w_ & 7), pn = w_ >> 3;
    if (ti >= ntile) continue;
    if (isHalf) body(ti, pn, half, std::true_type{}); else body(ti, pn, 0, std::false_type{});
  }
}


using s16x4 = __attribute__((ext_vector_type(4))) short;
using f32x16 = __attribute__((ext_vector_type(16))) float;
using u32x4 = __attribute__((ext_vector_type(4))) unsigned;
constexpr int AT_LDQ = 1536, AT_LDK = 1536, AT_LDV = 1024, AT_LDO = 1024;
constexpr int AT_SHM_V = 64 * 128 * 2, AT_SHM_K = 64 * 192 * 2;
constexpr int AT_SHM = 2 * AT_SHM_V + 2 * AT_SHM_K + 8 * 64 * 4;
constexpr float AT_SCALE = 0.07216878364870322f;
constexpr float AT_THR = 8.f;
#define KSWZ(row, colB) ((row) * 384 + ((colB) ^ (((row) & 7) << 4)))
#define SBAR() __builtin_amdgcn_sched_barrier(0)
__device__ __forceinline__ int crow(int r, int hi) { return (r & 3) + 8 * (r >> 2) + 4 * hi; }

__device__ __forceinline__ void partialSM(f32x16& p0, f32x16& p1, float& m_reg, float& mn, float& alpha) {
  constexpr float C = AT_SCALE * 1.4426950408889634f;
  float pmax = p0[0];
#pragma unroll
  for (int r = 1; r < 16; ++r) pmax = fmaxf(pmax, p0[r]);
#pragma unroll
  for (int r = 0; r < 16; ++r) pmax = fmaxf(pmax, p1[r]);
  { auto rr = __builtin_amdgcn_permlane32_swap(__float_as_uint(pmax), __float_as_uint(pmax), false, false);
    pmax = fmaxf(__uint_as_float(rr[0]), __uint_as_float(rr[1])); }
  if (__builtin_expect(__all(pmax - m_reg <= AT_THR / AT_SCALE), 1)) { mn = m_reg; alpha = 1.f; }
  else { mn = fmaxf(m_reg, pmax); alpha = __builtin_amdgcn_exp2f((m_reg - mn) * C); m_reg = mn; }
  float mnC = -mn * C;
#pragma unroll
  for (int r = 0; r < 16; ++r) p0[r] = fmaf(p0[r], C, mnC);
#pragma unroll
  for (int r = 0; r < 16; ++r) p1[r] = fmaf(p1[r], C, mnC);
#pragma unroll
  for (int r = 0; r < 16; ++r) p0[r] = __builtin_amdgcn_exp2f(p0[r]);
}
__device__ __forceinline__ void finishSM(f32x16& p0, f32x16& p1, float alpha, float& l_reg, bf16x8& pa0, bf16x8& pa1, bf16x8& pa2, bf16x8& pa3) {
#pragma unroll
  for (int r = 0; r < 16; ++r) p1[r] = __builtin_amdgcn_exp2f(p1[r]);
  float ps = 0;
#pragma unroll
  for (int r = 0; r < 16; ++r) ps += p0[r];
#pragma unroll
  for (int r = 0; r < 16; ++r) ps += p1[r];
  { auto rr = __builtin_amdgcn_permlane32_swap(__float_as_uint(ps), __float_as_uint(ps), false, false);
    ps = __uint_as_float(rr[0]) + __uint_as_float(rr[1]); }
  l_reg = l_reg * alpha + ps;
#define PK4(PP, BASE, OUT) do { unsigned a0 = pack2(PP[BASE + 0], PP[BASE + 1]), a1 = pack2(PP[BASE + 2], PP[BASE + 3]);   \
    unsigned b0 = pack2(PP[BASE + 4], PP[BASE + 5]), b1 = pack2(PP[BASE + 6], PP[BASE + 7]);                              \
    auto r0 = __builtin_amdgcn_permlane32_swap(a0, b0, false, false); auto r1 = __builtin_amdgcn_permlane32_swap(a1, b1, false, false); \
    u32x4 w = {r0[0], r1[0], r0[1], r1[1]}; OUT = *reinterpret_cast<bf16x8*>(&w); } while (0)
  PK4(p0, 0, pa0); PK4(p0, 8, pa1); PK4(p1, 0, pa2); PK4(p1, 8, pa3);
#undef PK4
}
__device__ __forceinline__ void qkt(f32x16& p0, f32x16& p1, const char* kbase, const int (&kb4)[4], const bf16x8* qr) {
  p0 = f32x16{}; p1 = f32x16{};
#pragma unroll
  for (int d0 = 0; d0 < 12; ++d0) {
    const char* a0 = kbase + kb4[d0 & 3] + (d0 >> 2) * 1024;
    bf16x8 b0 = *reinterpret_cast<const bf16x8*>(a0);
    bf16x8 b1 = *reinterpret_cast<const bf16x8*>(a0 + 12288);
    p0 = __builtin_amdgcn_mfma_f32_32x32x16_bf16(b0, qr[d0], p0, 0, 0, 0);
    p1 = __builtin_amdgcn_mfma_f32_32x32x16_bf16(b1, qr[d0], p1, 0, 0, 0); }
}
__device__ __forceinline__ int v_st(int k, int c) { const int kk = (k & ~0xC) | ((k & 4) << 1) | ((k & 8) >> 1); return ((kk >> 3) * 4 + (c >> 5)) * 512 + ((kk & 7) * 32 + (c & 31)) * 2; }
__device__ __forceinline__ int v_rd_base(int lane) { return ((lane & 3) << 3) | (((lane >> 2) & 3) << 6) | (((lane >> 4) & 1) << 5) | (((lane >> 5) & 1) << 8); }
constexpr int v_rd_off(int d0, int ks, int half) { return d0 * 512 + ks * 4096 + half * 2048; }
template <int OFF> __device__ __forceinline__ s16x4 tr_read(int vb) {
  s16x4 r; asm volatile("ds_read_b64_tr_b16 %0, %1 offset:%2" : "=&v"(r) : "v"(vb), "i"(OFF) : "memory"); return r;
}
template <int D0> __device__ __forceinline__ void pv_one(f32x16& od, int vb, bf16x8 pa0, bf16x8 pa1, bf16x8 pa2, bf16x8 pa3) {
  const s16x4 l0 = tr_read<v_rd_off(D0, 0, 0)>(vb), h0 = tr_read<v_rd_off(D0, 0, 1)>(vb), l1 = tr_read<v_rd_off(D0, 1, 0)>(vb), h1 = tr_read<v_rd_off(D0, 1, 1)>(vb);
  const s16x4 l2 = tr_read<v_rd_off(D0, 2, 0)>(vb), h2 = tr_read<v_rd_off(D0, 2, 1)>(vb), l3 = tr_read<v_rd_off(D0, 3, 0)>(vb), h3 = tr_read<v_rd_off(D0, 3, 1)>(vb);
  asm volatile("s_waitcnt lgkmcnt(0)" ::: "memory"); SBAR();
#define PK(L, H) (bf16x8){L[0], L[1], L[2], L[3], H[0], H[1], H[2], H[3]}
  od = __builtin_amdgcn_mfma_f32_32x32x16_bf16(pa0, PK(l0, h0), od, 0, 0, 0);
  od = __builtin_amdgcn_mfma_f32_32x32x16_bf16(pa1, PK(l1, h1), od, 0, 0, 0);
  od = __builtin_amdgcn_mfma_f32_32x32x16_bf16(pa2, PK(l2, h2), od, 0, 0, 0);
  od = __builtin_amdgcn_mfma_f32_32x32x16_bf16(pa3, PK(l3, h3), od, 0, 0, 0);
#undef PK
}
__device__ __forceinline__ void pv_d0(f32x16* o, int vb, bf16x8 pa0, bf16x8 pa1, bf16x8 pa2, bf16x8 pa3) {
  pv_one<0>(o[0], vb, pa0, pa1, pa2, pa3); pv_one<1>(o[1], vb, pa0, pa1, pa2, pa3); pv_one<2>(o[2], vb, pa0, pa1, pa2, pa3); pv_one<3>(o[3], vb, pa0, pa1, pa2, pa3);
}

template <int NTL, int NTC>
__device__ __forceinline__ void attn_body(const bf16* __restrict__ Qb, const bf16* __restrict__ Kh, const bf16* __restrict__ Vh,
                                          bf16* __restrict__ Ob, int lat0, int ctx0, char* lds, int wv) {
  constexpr int NT = NTL + NTC;
  const int tid = tidx(wv), wid = tid >> 6, lane = tid & 63, r32 = lane & 31, hi = lane >> 5;
  char* V_lds = lds; char* K_lds = lds + 2 * AT_SHM_V;
  float* ws = (float*)(lds + 2 * AT_SHM_V + 2 * AT_SHM_K) + wid * 64; float* li_l = ws; float* al_l = ws + 32;
  float m_reg = -1e30f, l_reg = 0; f32x16 o[4] = {}; bf16x8 qr[12];
  const bf16* Qw = Qb + (size_t)(wid * 32 + r32) * AT_LDQ + hi * 8;
#pragma unroll
  for (int d0 = 0; d0 < 12; ++d0) qr[d0] = *reinterpret_cast<const bf16x8*>(Qw + d0 * 16);
  unsigned kg[3], vg[2];
#pragma unroll
  for (int i = 0; i < 3; ++i) { const int blk = wid + 8 * i, rg = blk / 3, cg = blk % 3, rowpos = lane >> 3, chunkpos = lane & 7;
    const int r = rg * 8 + (rowpos ^ (rg & 1)), c16 = cg * 8 + (chunkpos ^ (r & 7)); kg[i] = (unsigned)(r * AT_LDK + c16 * 8); }
#pragma unroll
  for (int i = 0; i < 2; ++i) { const int P_ = (wid + 8 * i) * 1024 + lane * 16; const int sub = P_ / 512, within = (P_ % 512) / 2;
    const int kk = (sub >> 2) * 8 + within / 32, c = (sub & 3) * 32 + (within & 31); const int k = (kk & ~0xC) | ((kk & 4) << 1) | ((kk & 8) >> 1);
    vg[i] = (unsigned)(k * AT_LDV + c); }
  const int vb0 = (int)(uintptr_t)V_lds + v_rd_base(lane);
  int kb4[4];
#pragma unroll
  for (int q = 0; q < 4; ++q) kb4[q] = (r32 >> 3) * 3072 + (((r32 & 7) ^ ((r32 >> 3) & 1)) << 7) + ((((q << 1) | hi) ^ (r32 & 7)) << 4);
#define TOK0(t) ((t) < NTL ? lat0 + (t) * 64 : ctx0 + ((t) - NTL) * 64)
#define ISSUE(t, buf) do { const int _t0 = TOK0(t); const bf16* _kp = Kh + (size_t)_t0 * AT_LDK; const bf16* _vp = Vh + (size_t)_t0 * AT_LDV; \
    _Pragma("unroll") for (int _i = 0; _i < 3; ++_i) GLDS(_kp + kg[_i], K_lds + (buf) * AT_SHM_K + (wid + 8 * _i) * 1024 + lane * 16); \
    _Pragma("unroll") for (int _i = 0; _i < 2; ++_i) GLDS(_vp + vg[_i], V_lds + (buf) * AT_SHM_V + (wid + 8 * _i) * 1024 + lane * 16); } while (0)
#define ISSUE_K(t, buf) do { const bf16* _kp = Kh + (size_t)TOK0(t) * AT_LDK; \
    _Pragma("unroll") for (int _i = 0; _i < 3; ++_i) GLDS(_kp + kg[_i], K_lds + (buf) * AT_SHM_K + (wid + 8 * _i) * 1024 + lane * 16); } while (0)
#define ISSUE_V(t, buf) do { const bf16* _vp = Vh + (size_t)TOK0(t) * AT_LDV; \
    _Pragma("unroll") for (int _i = 0; _i < 2; ++_i) GLDS(_vp + vg[_i], V_lds + (buf) * AT_SHM_V + (wid + 8 * _i) * 1024 + lane * 16); } while (0)
#define LANDED() do { asm volatile("s_waitcnt vmcnt(0)" ::: "memory"); __builtin_amdgcn_s_barrier(); } while (0)
#define ST_QK(buf) do { SBAR(); qkt(p0, p1, K_lds + (buf) * AT_SHM_K, kb4, qr); SBAR(); } while (0)
#define ST_SM() do { partialSM(p0, p1, m_reg, mn, al); finishSM(p0, p1, al, l_reg, pa0, pa1, pa2, pa3); \
    if (__any(al < 1.f)) { if (hi == 0) al_l[r32] = al; asm volatile("s_waitcnt lgkmcnt(0)" ::: "memory"); \
      _Pragma("unroll") for (int d = 0; d < 4; ++d) _Pragma("unroll") for (int r = 0; r < 16; ++r) o[d][r] *= al_l[crow(r, hi)]; } SBAR(); } while (0)
#define ST_PV(buf) do { pv_d0(o, vb0 + (buf) * AT_SHM_V, pa0, pa1, pa2, pa3); SBAR(); } while (0)
  f32x16 p0, p1; float mn, al; bf16x8 pa0, pa1, pa2, pa3;
  ISSUE_K(0, 0); ISSUE_V(0, 0); LANDED();
  if (wv < 4) {
#pragma unroll 1
    for (int j = 0; j < NT; ++j) {
      const int buf = j & 1;
      if (j + 1 < NT) ISSUE_K(j + 1, buf ^ 1);
      ST_QK(buf);
      __builtin_amdgcn_s_barrier();
      if (j + 1 < NT) ISSUE_V(j + 1, buf ^ 1);
      ST_SM();
      __builtin_amdgcn_s_barrier();
      ST_PV(buf);
      LANDED();
    }
  } else {
#pragma unroll 1
    for (int j = 0; j < NT; ++j) {
      const int buf = j & 1;
      if (j + 1 < NT) ISSUE_K(j + 1, buf ^ 1);
      if (j > 0) ST_PV(buf ^ 1);
      __builtin_amdgcn_s_barrier();
      if (j + 1 < NT) ISSUE_V(j + 1, buf ^ 1);
      ST_QK(buf);
      __builtin_amdgcn_s_barrier();
      ST_SM();
      LANDED();
    }
    ST_PV((NT - 1) & 1);
  }
#undef ISSUE_K
#undef ISSUE_V
#undef ST_QK
#undef ST_SM
#undef ST_PV
  if (hi == 0) li_l[r32] = l_reg; asm volatile("s_waitcnt lgkmcnt(0)" ::: "memory");
  bf16* Ow = Ob + (size_t)(wid * 32) * AT_LDO;
#pragma unroll
  for (int r = 0; r < 16; ++r) { const int orow = crow(r, hi); const float rli = __builtin_amdgcn_rcpf(li_l[orow]);
#pragma unroll
    for (int d0 = 0; d0 < 4; ++d0) Ow[(size_t)orow * AT_LDO + d0 * 32 + r32] = f2bf(o[d0][r] * rli); }
  __syncthreads();
#undef ISSUE
#undef LANDED
#undef TOK0
}

__device__ __forceinline__ void attn_phase(const P& p, char* shm, int bid, int nb, bool do_ctx, int wv) {
  const bf16* Vbase = p.w.v;
  for (int u = bid; u < 1024; u += nb) {
    const int x = u & 7, y = (u >> 3) & 31, r = u >> 8;
    const int qb = y & 7, pair = x * 4 + (y >> 3) + 32 * r;
    const int b = pair >> 3, h = pair & 7;
    const int q0 = b * SEQ + qb * 256;
    attn_body<32, 4>(p.w.q + (size_t)q0 * AT_LDQ + h * 192, p.w.k + h * 192, Vbase + h * 128, p.w.o + (size_t)q0 * AT_LDO + h * 128, b * SEQ, NLAT + b * CTX, shm, wv);
  }
  if (do_ctx) {
    for (int u = bid; u < 128; u += nb) {
      const int b = u >> 3, h = u & 7;
      const int q0 = NLAT + b * CTX;
      attn_body<0, 4>(p.w.q + (size_t)q0 * AT_LDQ + h * 192, p.w.k + h * 192, Vbase + h * 128, p.w.o + (size_t)q0 * AT_LDO + h * 128, 0, NLAT + b * CTX, shm, wv);
    }
  }
}


__device__ __forceinline__ void filter_phase(const P& p, char* shm, int bid, int nb, int wv) {
  float* wl = (float*)shm;
  float* vs = (float*)shm + 1024;
  const int T = tidx(wv), wid = T >> 6;
  for (int u = bid; u < 2 * 2 * 128; u += nb) {
    const int v = u >> 8, j = (u >> 7) & 1, c0 = (u & 127) * 8;
    const int L = v ? 256 : 2048, p0 = v ? 2048 : 0, xoff = v ? 4096 : 0;
    const int NI = v ? 1 : 4;
    const float* hf = p.w.hf + ((size_t)j * 2304 + p0) * 64;
    const float* w3 = p.hy_f_w3 + (size_t)j * 64 * 2048;
    const float min_decay = logf(1e-2f) / 1.5f, max_decay = logf(1e-2f) / 0.3f;
    __syncthreads();
    for (int e = T; e < 1024; e += 512) { const int n = e >> 4, q2 = e & 15; wl[e] = w3[n * 2048 + (q2 < 8 ? c0 + q2 : 1024 + c0 + q2 - 8)]; }
    __syncthreads();
    float asum[8];
#pragma unroll
    for (int q = 0; q < 8; ++q) asum[q] = 0.f;
#pragma unroll 1
    for (int i = 0; i < NI; ++i) {
      const int t = T + 512 * i;
      const bool act = t < L;
      float h[64];
      {
        const float4* h4 = (const float4*)(hf + (size_t)(act ? t : 0) * 64);
#pragma unroll
        for (int q = 0; q < 16; ++q) { const float4 x = h4[q]; h[q * 4] = x.x; h[q * 4 + 1] = x.y; h[q * 4 + 2] = x.z; h[q * 4 + 3] = x.w; }
      }
      float acc[16];
#pragma unroll
      for (int q = 0; q < 16; ++q) acc[q] = 0.f;
#pragma unroll
      for (int n = 0; n < 64; ++n) {
#pragma unroll
        for (int q4 = 0; q4 < 4; ++q4) {
          const float4 w = *(const float4*)(wl + n * 16 + q4 * 4);
          acc[q4 * 4] += h[n] * w.x; acc[q4 * 4 + 1] += h[n] * w.y; acc[q4 * 4 + 2] += h[n] * w.z; acc[q4 * 4 + 3] += h[n] * w.w;
        }
      }
      const float tn = (float)t / (float)(L - 1);
#pragma unroll
      for (int q = 0; q < 8; ++q) {
        const int c = c0 + q;
        const float ad = fabsf(min_decay + (float)c * ((max_decay - min_decay) / 1023.f));
        const float dec = expf(-tn * ad);
        float a = acc[q] * dec, b = acc[8 + q] * dec;
        if (!act) { a = 0.f; b = 0.f; }
        if (t == 0) b = 0.f;
        asum[q] += fabsf(a) + fabsf(b);
        vs[(i * 16 + q) * 512 + T] = a; vs[(i * 16 + 8 + q) * 512 + T] = b;
      }
    }
    __syncthreads();
#pragma unroll
    for (int q = 0; q < 8; ++q) { const float sv = wave_sum(asum[q]); if ((T & 63) == 0) wl[wid * 8 + q] = sv; }
    __syncthreads();
    float inv[8];
#pragma unroll
    for (int q = 0; q < 8; ++q) {
      float tot = 0.f;
#pragma unroll
      for (int w8 = 0; w8 < 8; ++w8) tot += wl[w8 * 8 + q];
      inv[q] = 1.f / tot;
    }
#pragma unroll 1
    for (int i = 0; i < NI; ++i) {
      const int t = T + 512 * i;
      if (t < L) {
#pragma unroll
        for (int q = 0; q < 8; ++q) {
          bf16* rf = p.w.rf + ((size_t)j * 1024 + c0 + q) * 4608 + xoff;
          rf[L - t] = f2bf(vs[(i * 16 + q) * 512 + T] * inv[q]);
          if (t >= 1) rf[L + t] = f2bf(vs[(i * 16 + 8 + q) * 512 + T] * inv[q]); else rf[0] = f2bf(0.f);
        }
      }
    }
  }
}

template <int NB8>
__device__ __forceinline__ void toep_wave(const char* ldsA, const char* ldsB, f32x4 (&acc)[16]) {
  bf16x8 ring[16]; bf16x8 bfr[2];
#pragma unroll
  for (int u = -15; u <= 0; ++u) ring[u & 15] = *(const bf16x8*)(ldsA + 32 + 32 * u);
  bfr[0] = *(const bf16x8*)(ldsB);
#pragma unroll 1
  for (int B = 0; B < NB8; ++B) {
#pragma unroll
    for (int bb = 0; bb < 8; ++bb) {
      acc[15] = __builtin_amdgcn_mfma_f32_16x16x32_bf16(ring[(2 * bb - 15) & 15], bfr[bb & 1], acc[15], 0, 0, 0);
      acc[14] = __builtin_amdgcn_mfma_f32_16x16x32_bf16(ring[(2 * bb - 14) & 15], bfr[bb & 1], acc[14], 0, 0, 0);
      if (bb < 7 || B + 1 < NB8) {
        ring[(2 * bb + 1) & 15] = *(const bf16x8*)(ldsA + 64 * bb + 64);
        ring[(2 * bb + 2) & 15] = *(const bf16x8*)(ldsA + 64 * bb + 96);
        bfr[(bb + 1) & 1] = *(const bf16x8*)(ldsB + 64 * (bb + 1));
      }
#pragma unroll
      for (int a = 13; a >= 0; --a)
        acc[a] = __builtin_amdgcn_mfma_f32_16x16x32_bf16(ring[(2 * bb - a) & 15], bfr[bb & 1], acc[a], 0, 0, 0);
      __builtin_amdgcn_sched_barrier(0);
    }
    ldsA += 512; ldsB += 512;
  }
}


__device__ __forceinline__ void conv8(const uint4 ch, float prev, float next, float w0, float w1, float w2, float bias, float (&out)[8]) {
  float u[10];
  u[0] = prev; u[1] = bflo(ch.x); u[2] = bfhi(ch.x); u[3] = bflo(ch.y); u[4] = bfhi(ch.y); u[5] = bflo(ch.z); u[6] = bfhi(ch.z); u[7] = bflo(ch.w); u[8] = bfhi(ch.w); u[9] = next;
#pragma unroll
  for (int i = 0; i < 8; ++i) out[i] = u[i] * w0 + u[i + 1] * w1 + u[i + 2] * w2 + bias;
}

template <int L>
__device__ __forceinline__ void toep_unit(const P& p, char* shm, int unit, int wv) {
  constexpr int TEAM = L == 2048 ? 512 : 64;
  constexpr int CS = 4 * L + 16, RS = 2 * L + 16;
  constexpr int REG = 16 * RS;
  static_assert(8 * CS <= REG, "region");
  constexpr int CPT = 16 * L / 8 / TEAM;
  int T = tidx(wv); asm volatile("" : "+v"(T));
  const int wid = T >> 6, lane = T & 63;
  const int tt = L == 2048 ? T : lane;
  const int cb0 = tt / (L / 8), ct8 = (tt % (L / 8)) * 8;
  const int ldsch = cb0 * RS + ct8 * 2, gch = cb0 * L + ct8;
  const int c = L == 2048 ? unit : unit * 8 + wid;
  char* RC = shm + (L == 2048 ? 0 : wid * 2 * REG);
  char* VG = RC + REG;
  const int tok0 = L == 2048 ? 0 : NLAT;
  const bf16* zx0 = p.w.zT + (size_t)c * NALL + tok0;
  const bf16* zx1 = p.w.zT + (size_t)(1024 + c) * NALL + tok0;
  const bf16* zv = p.w.zT + (size_t)(2048 + c) * NALL + tok0;
  const float* cw = p.hy_conv_w + (size_t)p.j * 3 * 3072;
  const float* cb = p.hy_conv_b + (size_t)p.j * 3072;
  __syncthreads();
  {
    const bf16* rf = p.w.rf + ((size_t)p.j * 1024 + c) * 4608 + (L == 2048 ? 0 : 4096);
    constexpr int NCH = 2 * L / 8;
    const uint4 lo = *(const uint4*)(rf + tt * 8);
    uint4 hi4 = make_uint4(0, 0, 0, 0);
    if (tt + 1 < NCH) hi4 = *(const uint4*)(rf + tt * 8 + 8);
    const unsigned in[9] = {lo.x, lo.y, lo.z, lo.w, hi4.x, hi4.y, hi4.z, hi4.w, 0u};
#pragma unroll
    for (int k = 0; k < 8; ++k) {
      unsigned o4[4];
#pragma unroll
      for (int i = 0; i < 4; ++i) {
        const unsigned a = in[i + k / 2], b = in[i + k / 2 + 1];
        o4[i] = (k & 1) ? ((a >> 16) | (b << 16)) : a;
      }
      *(uint4*)(RC + k * CS + tt * 16) = make_uint4(o4[0], o4[1], o4[2], o4[3]);
    }
  }
  {
    const float w10 = cw[1024 + c], w11 = cw[3072 + 1024 + c], w12 = cw[2 * 3072 + 1024 + c], b1 = cb[1024 + c];
    const float wv0 = cw[2048 + c], wv1 = cw[3072 + 2048 + c], wv2 = cw[2 * 3072 + 2048 + c], bv = cb[2048 + c];
#pragma unroll 2
    for (int q = 0; q < CPT; ++q) {
      const int t8 = ct8;
      const size_t off = (size_t)(gch + q * 2 * L);
      const uint4 c1 = *(const uint4*)(zx1 + off), cv = *(const uint4*)(zv + off);
      float p1 = 0.f, n1 = 0.f, pv = 0.f, nv = 0.f;
      if (t8 > 0) { p1 = bf2f(zx1[off - 1]); pv = bf2f(zv[off - 1]); }
      if (t8 + 8 < L) { n1 = bf2f(zx1[off + 8]); nv = bf2f(zv[off + 8]); }
      float o1[8], ov[8];
      conv8(c1, p1, n1, w10, w11, w12, b1, o1);
      conv8(cv, pv, nv, wv0, wv1, wv2, bv, ov);
      uint4 r;
      r.x = pack2(o1[0] * ov[0], o1[1] * ov[1]); r.y = pack2(o1[2] * ov[2], o1[3] * ov[3]);
      r.z = pack2(o1[4] * ov[4], o1[5] * ov[5]); r.w = pack2(o1[6] * ov[6], o1[7] * ov[7]);
      *(uint4*)(VG + ldsch + q * 2 * RS) = r;
    }
  }
  static_assert(CPT == 8, "8 chunks per thread");
#define X0LD(q) const uint4 x0r##q = *(const uint4*)(zx0 + gch + q * 2 * L)
  X0LD(0); X0LD(1); X0LD(2); X0LD(3); X0LD(4); X0LD(5); X0LD(6); X0LD(7);
#undef X0LD
  __syncthreads();
  const int i16 = lane & 15, g = lane >> 4;
  const int tw = L == 2048 ? wid * 256 : 0;
  f32x4 acc[16];
#pragma unroll
  for (int a = 0; a < 16; ++a) acc[a] = f32x4{0.f, 0.f, 0.f, 0.f};
  {
    const int cpy = (8 - (i16 & 7)) & 7, ru8 = i16 + cpy;
    const char* ldsA = RC + cpy * CS + 2 * (L + 8 * g - ru8) - 2 * tw - 32;
    const char* ldsB = VG + i16 * RS + 16 * g;
    toep_wave<L / 256>(ldsA, ldsB, acc);
  }
  __syncthreads();
#define X0ST(q) *(uint4*)(RC + ldsch + q * 2 * RS) = x0r##q
  X0ST(0); X0ST(1); X0ST(2); X0ST(3); X0ST(4); X0ST(5); X0ST(6); X0ST(7);
#undef X0ST
  __syncthreads();
  {
    const float w00 = cw[c], w01 = cw[3072 + c], w02 = cw[2 * 3072 + c], b0 = cb[c];
    const float fb = p.hy_f_bias[p.j * 1024 + c];
    const int b = i16;
#pragma unroll
    for (int a = 0; a < 16; ++a) {
      const int t = tw + 16 * a + 4 * g;
      const char* xr = RC + b * RS + t * 2;
      const uint2 xc = *(const uint2*)xr;
      const float xp = t > 0 ? bf2f(*(const bf16*)(xr - 2)) : 0.f;
      const float xn = t + 4 < L ? bf2f(*(const bf16*)(xr + 8)) : 0.f;
      const float x0 = bflo(xc.x), x1 = bfhi(xc.x), x2 = bflo(xc.y), x3 = bfhi(xc.y);
      const float c0 = xp * w00 + x0 * w01 + x1 * w02 + b0;
      const float c1 = x0 * w00 + x1 * w01 + x2 * w02 + b0;
      const float c2 = x1 * w00 + x2 * w01 + x3 * w02 + b0;
      const float c3 = x2 * w00 + x3 * w01 + xn * w02 + b0;
      char* vr = VG + b * RS + t * 2;
      const uint2 vv = *(const uint2*)vr;
      uint2 o;
      o.x = pack2((acc[a][0] + bflo(vv.x) * fb) * c0, (acc[a][1] + bfhi(vv.x) * fb) * c1);
      o.y = pack2((acc[a][2] + bflo(vv.y) * fb) * c2, (acc[a][3] + bfhi(vv.y) * fb) * c3);
      *(uint2*)vr = o;
    }
  }
  __syncthreads();
  {
    bf16* dst = p.w.ygT + (size_t)c * NALL + tok0;
#pragma unroll
    for (int q = 0; q < CPT; ++q) *(uint4*)(dst + gch + q * 2 * L) = *(const uint4*)(VG + ldsch + q * 2 * RS);
  }
}

__device__ __forceinline__ void toep_steps8(bf16x8 (&ring)[16], bf16x8 (&bfr)[2], f32x4 (&acc)[16], const char* ldsA, const char* ldsB, bool more) {
#pragma unroll
  for (int bb = 0; bb < 8; ++bb) {
    acc[15] = __builtin_amdgcn_mfma_f32_16x16x32_bf16(ring[(2 * bb - 15) & 15], bfr[bb & 1], acc[15], 0, 0, 0);
    acc[14] = __builtin_amdgcn_mfma_f32_16x16x32_bf16(ring[(2 * bb - 14) & 15], bfr[bb & 1], acc[14], 0, 0, 0);
    if (bb < 7 || more) {
      ring[(2 * bb + 1) & 15] = *(const bf16x8*)(ldsA + 64 * bb + 64);
      ring[(2 * bb + 2) & 15] = *(const bf16x8*)(ldsA + 64 * bb + 96);
    }
    if (bb < 7) bfr[(bb + 1) & 1] = *(const bf16x8*)(ldsB + 64 * (bb + 1));
#pragma unroll
    for (int a = 13; a >= 0; --a)
      acc[a] = __builtin_amdgcn_mfma_f32_16x16x32_bf16(ring[(2 * bb - a) & 15], bfr[bb & 1], acc[a], 0, 0, 0);
    __builtin_amdgcn_sched_barrier(0);
  }
}

__device__ __forceinline__ void toep_unit_lat(const P& p, char* shm, int c, int wv) {
  constexpr int L = 2048;
  constexpr int CS = 4 * L + 16, RS = 2 * L + 16, REG = 16 * RS;
  int T = tidx(wv); asm volatile("" : "+v"(T));
  const int wid = T >> 6, lane = T & 63;
  const int cb0 = T >> 8, ct8 = (T & 255) * 8;
  const int ldsch = cb0 * RS + ct8 * 2, gch = cb0 * L + ct8;
  const int bb_ = T >> 5, bt8 = (T & 31) * 8;
  const int lblk = bb_ * RS + bt8 * 2, gblk = bb_ * L + bt8;
  char* RC = shm; char* VG = RC + REG;
  const bf16* zx0 = p.w.zT + (size_t)c * NALL;
  const bf16* zx1 = p.w.zT + (size_t)(1024 + c) * NALL;
  const bf16* zv = p.w.zT + (size_t)(2048 + c) * NALL;
  const float* cw = p.hy_conv_w + (size_t)p.j * 3 * 3072;
  const float* cb = p.hy_conv_b + (size_t)p.j * 3072;
  const float w10 = cw[1024 + c], w11 = cw[3072 + 1024 + c], w12 = cw[2 * 3072 + 1024 + c], b1 = cb[1024 + c];
  const float wv0 = cw[2048 + c], wv1 = cw[3072 + 2048 + c], wv2 = cw[2 * 3072 + 2048 + c], bv = cb[2048 + c];
#define BLK_LOAD(S, k) do { const int o_ = gblk + (k) * 256; const int t_ = (k) * 256 + bt8; \
    S##c1 = *(const uint4*)(zx1 + o_); S##cv = *(const uint4*)(zv + o_); \
    const int op_ = t_ > 0 ? o_ - 1 : o_; const int on_ = t_ + 8 < L ? o_ + 8 : o_; \
    S##p1 = *(const unsigned short*)(zx1 + op_); S##pv = *(const unsigned short*)(zv + op_); \
    S##n1 = *(const unsigned short*)(zx1 + on_); S##nv = *(const unsigned short*)(zv + on_); } while (0)
#define BLK_CONV(S, k) do { const int t_ = (k) * 256 + bt8; \
    const float fp1 = t_ > 0 ? __uint_as_float((unsigned)S##p1 << 16) : 0.f, fpv = t_ > 0 ? __uint_as_float((unsigned)S##pv << 16) : 0.f; \
    const float fn1 = t_ + 8 < L ? __uint_as_float((unsigned)S##n1 << 16) : 0.f, fnv = t_ + 8 < L ? __uint_as_float((unsigned)S##nv << 16) : 0.f; \
    float o1[8], ov[8]; conv8(S##c1, fp1, fn1, w10, w11, w12, b1, o1); conv8(S##cv, fpv, fnv, wv0, wv1, wv2, bv, ov); \
    uint4 r_; r_.x = pack2(o1[0] * ov[0], o1[1] * ov[1]); r_.y = pack2(o1[2] * ov[2], o1[3] * ov[3]); \
    r_.z = pack2(o1[4] * ov[4], o1[5] * ov[5]); r_.w = pack2(o1[6] * ov[6], o1[7] * ov[7]); \
    *(uint4*)(VG + lblk + (k) * 512) = r_; } while (0)
  uint4 Ac1, Acv, Bc1, Bcv; unsigned short Ap1, Apv, An1, Anv, Bp1, Bpv, Bn1, Bnv;
  __syncthreads();
  BLK_LOAD(A, 0); BLK_LOAD(B, 1);
  {
    const bf16* rf = p.w.rf + ((size_t)p.j * 1024 + c) * 4608;
    const uint4 lo = *(const uint4*)(rf + T * 8);
    uint4 hi4 = make_uint4(0, 0, 0, 0);
    if (T + 1 < 512) hi4 = *(const uint4*)(rf + T * 8 + 8);
    const unsigned in[9] = {lo.x, lo.y, lo.z, lo.w, hi4.x, hi4.y, hi4.z, hi4.w, 0u};
#pragma unroll
    for (int k = 0; k < 8; ++k) {
      unsigned o4[4];
#pragma unroll
      for (int i = 0; i < 4; ++i) { const unsigned a = in[i + k / 2], b = in[i + k / 2 + 1]; o4[i] = (k & 1) ? ((a >> 16) | (b << 16)) : a; }
      *(uint4*)(RC + k * CS + T * 16) = make_uint4(o4[0], o4[1], o4[2], o4[3]);
    }
  }
  BLK_CONV(A, 0);
#define X0LD(q) const uint4 x0r##q = *(const uint4*)(zx0 + gch + q * 2 * L)
  X0LD(0); X0LD(1); X0LD(2); X0LD(3); X0LD(4); X0LD(5); X0LD(6); X0LD(7);
#undef X0LD
  const int i16 = lane & 15, g = lane >> 4;
  const int tw = wid * 256;
  f32x4 acc[16];
#pragma unroll
  for (int a = 0; a < 16; ++a) acc[a] = f32x4{0.f, 0.f, 0.f, 0.f};
  const int cpy = (8 - (i16 & 7)) & 7, ru8 = i16 + cpy;
  const char* ldsA = RC + cpy * CS + 2 * (L + 8 * g - ru8) - 2 * tw - 32;
  const char* ldsB = VG + i16 * RS + 16 * g;
  bf16x8 ring[16]; bf16x8 bfr[2];
  __syncthreads();
#pragma unroll
  for (int u = -15; u <= 0; ++u) ring[u & 15] = *(const bf16x8*)(ldsA + 32 + 32 * u);
#pragma unroll 1
  for (int k = 0; k < 8; k += 2) {
    if (k + 2 < 8) BLK_LOAD(A, k + 2);
    bfr[0] = *(const bf16x8*)(ldsB);
    toep_steps8(ring, bfr, acc, ldsA, ldsB, true);
    ldsA += 512; ldsB += 512;
    BLK_CONV(B, k + 1);
    __syncthreads();
    if (k + 3 < 8) BLK_LOAD(B, k + 3);
    bfr[0] = *(const bf16x8*)(ldsB);
    toep_steps8(ring, bfr, acc, ldsA, ldsB, k + 2 < 8);
    ldsA += 512; ldsB += 512;
    if (k + 2 < 8) BLK_CONV(A, k + 2);
    __syncthreads();
  }
#undef BLK_LOAD
#undef BLK_CONV
#define X0ST(q) *(uint4*)(RC + ldsch + q * 2 * RS) = x0r##q
  X0ST(0); X0ST(1); X0ST(2); X0ST(3); X0ST(4); X0ST(5); X0ST(6); X0ST(7);
#undef X0ST
  __syncthreads();
  {
    const float w00 = cw[c], w01 = cw[3072 + c], w02 = cw[2 * 3072 + c], b0 = cb[c];
    const float fb = p.hy_f_bias[p.j * 1024 + c];
    const int b = i16;
#pragma unroll
    for (int a = 0; a < 16; ++a) {
      const int t = tw + 16 * a + 4 * g;
      const char* xr = RC + b * RS + t * 2;
      const uint2 xc = *(const uint2*)xr;
      const float xp = t > 0 ? bf2f(*(const bf16*)(xr - 2)) : 0.f;
      const float xn = t + 4 < L ? bf2f(*(const bf16*)(xr + 8)) : 0.f;
      const float x0 = bflo(xc.x), x1 = bfhi(xc.x), x2 = bflo(xc.y), x3 = bfhi(xc.y);
      const float c0 = xp * w00 + x0 * w01 + x1 * w02 + b0;
      const float c1 = x0 * w00 + x1 * w01 + x2 * w02 + b0;
      const float c2 = x1 * w00 + x2 * w01 + x3 * w02 + b0;
      const float c3 = x2 * w00 + x3 * w01 + xn * w02 + b0;
      char* vr = VG + b * RS + t * 2;
      const uint2 vv = *(const uint2*)vr;
      uint2 o;
      o.x = pack2((acc[a][0] + bflo(vv.x) * fb) * c0, (acc[a][1] + bfhi(vv.x) * fb) * c1);
      o.y = pack2((acc[a][2] + bflo(vv.y) * fb) * c2, (acc[a][3] + bfhi(vv.y) * fb) * c3);
      *(uint2*)vr = o;
    }
  }
  __syncthreads();
  {
    bf16* dst = p.w.ygT + (size_t)c * NALL;
#pragma unroll
    for (int q = 0; q < 8; ++q) *(uint4*)(dst + gch + q * 2 * L) = *(const uint4*)(VG + ldsch + q * 2 * RS);
  }
}
constexpr int TOEP_SHM = 2 * 16 * (2 * 2048 + 16);
constexpr int TOEP_SHM_C = 8 * 2 * 16 * (2 * 256 + 16);
__device__ __forceinline__ void toep_phase(const P& p, char* shm, int bid, int nb, int wv) {
  for (int u = bid; u < 1024; u += nb) toep_unit_lat(p, shm, u, wv);
  for (int u = bid; u < 128; u += nb) toep_unit<256>(p, shm, u, wv);
}

__device__ __forceinline__ void transpose_phase(const P& p, char* shm, int bid, int nb, int wv) {
  unsigned short* tile = (unsigned short*)shm;
  float* red = (float*)(shm + 65536);
  const int T = tidx(wv);
  const int tok = T & 31, cg = T >> 5;
  for (int u = bid; u < NALL / 32; u += nb) {
    const int t0 = u * 32;
    __syncthreads();
#pragma unroll
    for (int q = 0; q < 8; ++q) {
      const int ch = (T >> 2) + q * 128, k8 = (T & 3) * 8;
      *(uint4*)(tile + ch * 32 + k8) = *(const uint4*)(p.w.ygT + (size_t)ch * NALL + t0 + k8);
    }
    __syncthreads();
    float am = 0.f;
#pragma unroll 8
    for (int c = 0; c < 64; ++c) am = fmaxf(am, fabsf(__uint_as_float((unsigned)tile[(cg * 64 + c) * 32 + tok] << 16)));
    red[cg * 32 + tok] = am;
    __syncthreads();
    if (T < 32) {
      float m = 0.f;
#pragma unroll
      for (int q = 0; q < 16; ++q) m = fmaxf(m, red[q * 32 + T]);
      const float sc = m > 0.f ? m * (1.f / 127.f) : 1.f;
      p.w.syg[t0 + T] = sc;
      red[512 + T] = 1.f / sc;
    }
    __syncthreads();
    const float inv = red[512 + tok];
    unsigned ow[16];
#pragma unroll
    for (int w4 = 0; w4 < 16; ++w4) {
      unsigned pk = 0;
#pragma unroll
      for (int e = 0; e < 4; ++e) {
        const float v = __uint_as_float((unsigned)tile[(cg * 64 + w4 * 4 + e) * 32 + tok] << 16);
        pk |= ((unsigned)((int)rintf(v * inv) & 255)) << (8 * e);
      }
      ow[w4] = pk;
    }
    uint4* dst = (uint4*)(p.w.yg8 + (size_t)(t0 + tok) * 1024 + cg * 64);
#pragma unroll
    for (int q = 0; q < 4; ++q) dst[q] = make_uint4(ow[q * 4], ow[q * 4 + 1], ow[q * 4 + 2], ow[q * 4 + 3]);
  }
}


#define XB_TMO      128
#define XB_XCNT(j)  (256  + 64 * (j))
#define XB_XSUB(j)  (1280 + 64 * (j))
#define XB_XGEN(j)  (2304 + 64 * (j))
#define XB_TOP      3328
#define XB_TOPGEN   3392
#define XCD_BAR_WORDS 3456
#define XB_SPIN_CAP (1u << 22)
#define LAS __attribute__((address_space(3)))
__device__ __forceinline__ unsigned xb_ld(unsigned* p)              { return __hip_atomic_load(p, __ATOMIC_RELAXED, __HIP_MEMORY_SCOPE_AGENT); }
__device__ __forceinline__ unsigned xb_add(unsigned* p, unsigned v) { return __hip_atomic_fetch_add(p, v, __ATOMIC_RELAXED, __HIP_MEMORY_SCOPE_AGENT); }
__device__ __forceinline__ unsigned xb_xcc_id() { return (unsigned)__builtin_amdgcn_s_getreg((3 << 11) | 20) & 0xFu; }
#define XB_SPIN(cond, bar) do { unsigned _sp = 0; while (cond) { __builtin_amdgcn_s_sleep(1); \
    if ((++_sp & 255u) == 0u) { if (xb_ld(&(bar)[XB_TMO])) break; if (_sp > XB_SPIN_CAP) { atomicAdd(&(bar)[XB_TMO], 1u); break; } } } } while (0)
struct XcdBarrier { unsigned* bar; unsigned x; volatile LAS unsigned* st; };
__device__ __forceinline__ XcdBarrier xcd_barrier_post(unsigned* bar, volatile LAS unsigned* st) {
  XcdBarrier b; b.bar = bar; b.x = xb_xcc_id(); b.st = st;
  if (threadIdx.x == 0) (void)xb_add(&bar[XB_XCNT(b.x)], 1u);
  return b;
}
__device__ __forceinline__ void xcd_barrier_complete(unsigned* bar, unsigned x, unsigned& nloc, unsigned& nx) {
  const unsigned G = gridDim.x * gridDim.y * gridDim.z;
  unsigned sum, cnt, mine, sp = 0u;
  for (;;) {
    sum = 0u; cnt = 0u; mine = 0u;
#pragma unroll
    for (unsigned j = 0; j < 16; ++j) { const unsigned c = xb_ld(&bar[XB_XCNT(j)]); sum += c; cnt += (c > 0u) ? 1u : 0u; mine = (j == x) ? c : mine; }
    if (sum == G) break;
    __builtin_amdgcn_s_sleep(1);
    if ((++sp & 255u) == 0u) { if (xb_ld(&bar[XB_TMO])) break; if (sp > XB_SPIN_CAP) { atomicAdd(&bar[XB_TMO], 1u); break; } }
  }
  nloc = mine > 0u ? mine : 1u; nx = cnt > 0u ? cnt : 1u;
}
__device__ __forceinline__ void xcd_barrier(const XcdBarrier& b, int wv) {
  asm volatile("s_waitcnt vmcnt(0)" ::: "memory");
  __syncthreads();
  if (tidx(wv) == 0) {
    unsigned* bar = b.bar;
    __builtin_amdgcn_s_waitcnt(0);
    unsigned nloc = b.st[0], nx = b.st[1];
    if (nloc == 0u) { xcd_barrier_complete(bar, b.x, nloc, nx); b.st[0] = nloc; b.st[1] = nx; }
    const unsigned old = xb_add(&bar[XB_XSUB(b.x)], 1u);
    const unsigned gen = old / nloc;
    if (old + 1u == (gen + 1u) * nloc) {
      __builtin_amdgcn_fence(__ATOMIC_RELEASE, "agent");
      asm volatile("s_waitcnt vmcnt(0)" ::: "memory");
      const unsigned og = xb_add(&bar[XB_TOP], 1u);
      const unsigned tg = og / nx;
      if (og + 1u == (tg + 1u) * nx) xb_add(&bar[XB_TOPGEN], 1u);
      else XB_SPIN(xb_ld(&bar[XB_TOPGEN]) == tg, bar);
      __builtin_amdgcn_fence(__ATOMIC_ACQUIRE, "agent");
      xb_add(&bar[XB_XGEN(b.x)], 1u);
      asm volatile("s_waitcnt vmcnt(0)" ::: "memory");
    } else {
      XB_SPIN(xb_ld(&bar[XB_XGEN(b.x)]) == gen, bar);
      __builtin_amdgcn_fence(__ATOMIC_ACQUIRE, "agent");
      asm volatile("s_waitcnt vmcnt(0)" ::: "memory");
    }
  }
  __syncthreads();
}

__device__ __forceinline__ void mod_phase(const P& p, char* shm, int bid, int nb, int wv) {
  float* sl = (float*)shm;
  const int T = tidx(wv);
  for (int u = bid; u < 4 * 12 * 16; u += nb) {
    const int i = u / 192, rem = u % 192, nblk = rem >> 4, ks = rem & 15;
    __syncthreads();
    for (int e = T; e < 17 * 64; e += 512) {
      const int r = e >> 6, k = e & 63;
      const float v = r < 16 ? p.c[r * 1024 + ks * 64 + k] : p.c_ctx[ks * 64 + k];
      sl[e] = silu_f(v);
    }
    __syncthreads();
    const int n = nblk * 512 + T;
    float acc[17];
#pragma unroll
    for (int r = 0; r < 17; ++r) acc[r] = 0.f;
    const float* wp = p.ada_w + ((size_t)i * 1024 + ks * 64) * 6144 + n;
#pragma unroll 1
    for (int k0 = 0; k0 < 64; k0 += 16) {
      float wv16[16];
#pragma unroll
      for (int k = 0; k < 16; ++k) wv16[k] = wp[(size_t)(k0 + k) * 6144];
#pragma unroll
      for (int k = 0; k < 16; ++k)
#pragma unroll
        for (int r = 0; r < 17; ++r) acc[r] += sl[r * 64 + k0 + k] * wv16[k];
    }
#pragma unroll
    for (int r = 0; r < 17; ++r) p.w.modp[(((size_t)ks * 4 + i) * 17 + r) * 6144 + n] = acc[r];
  }
}
__device__ __forceinline__ void modreduce_phase(const P& p, int bid, int nb, int wv) {
  constexpr int TOT = 4 * 17 * 6144;
  for (int idx = bid * 512 + tidx(wv); idx < TOT; idx += nb * 512) {
    const int i = idx / (17 * 6144), n = idx % 6144;
    float a = p.ada_b[i * 6144 + n];
#pragma unroll
    for (int ks = 0; ks < 16; ++ks) a += p.w.modp[(size_t)ks * TOT + idx];
    p.w.mod[idx] = a;
  }
}
__device__ __forceinline__ void fhid_phase(const P& p, int bid, int nb, int wv) {
  const int wid = tidx(wv) >> 6, n = tidx(wv) & 63;
  for (int u = bid * 8 + wid; u < 2 * 2304; u += nb * 8) {
    const int j = u / 2304, pp = u % 2304;
    const int L = pp < 2048 ? 2048 : 256;
    const int t = pp < 2048 ? pp : pp - 2048;
    float zn = 0.f;
    if (n == 0) zn = (float)t / (float)(L - 1);
    else if (n < 33) {
      const int bi = (n - 1) % 16;
      const double band = 1e-4 + (double)bi * ((15.0 - 1e-4) / 15.0);
      double x = band * (double)t / (double)L;
      x -= floor(x);
      const float xf = (float)x;
      zn = n <= 16 ? cospif(2.f * xf) : -sinpif(2.f * xf);
    }
    const float fr = p.hy_sin_freq[j * 64 + n];
    float a = p.hy_f_b1[j * 64 + n];
    for (int k = 0; k < 33; ++k) a += __int_as_float(__builtin_amdgcn_readlane(__float_as_int(zn), k)) * p.hy_f_w1[(j * 33 + k) * 64 + n];
    float hv = sinf(fr * a);
    for (int m = 0; m < 2; ++m) {
      a = p.hy_f_b2[(j * 2 + m) * 64 + n];
      for (int k = 0; k < 64; ++k) a += __int_as_float(__builtin_amdgcn_readlane(__float_as_int(hv), k)) * p.hy_f_w2[((size_t)(j * 2 + m) * 64 + k) * 64 + n];
      hv = sinf(fr * a);
    }
    p.w.hf[((size_t)j * 2304 + pp) * 64 + n] = hv;
  }
}
__device__ __forceinline__ void ropetab_phase(const P& p, int bid, int nb, int wv) {
  for (int gid = bid * 512 + tidx(wv); gid < 64 * 16; gid += nb * 512) {
    const int pos = gid / 16, i = gid % 16;
    const double inv = pow(10000.0, -(double)(2 * i) / 32.0);
    const double a = (double)pos * inv;
    p.w.cs[gid * 2] = (float)cos(a);
    p.w.cs[gid * 2 + 1] = (float)sin(a);
  }
}

__device__ __forceinline__ void norm_mix_phase(const P& p, int bid, int nb, int wv) {
  const int wid = tidx(wv) >> 6, lane = tidx(wv) & 63;
  const float* g = p.norm_mix_g + p.layer * 1024;
  for (int rb = (bid * 8 + wid) * 4; rb < NALL; rb += nb * 32) {
    float4 v[4][4];
#pragma unroll
    for (int r = 0; r < 4; ++r) {
      const int row = rb + r;
      if (p.layer == 0) {
        const float* xr = row < NLAT ? p.x + (size_t)row * 1024 : p.ctx + (size_t)(row - NLAT) * 1024;
#pragma unroll
        for (int i = 0; i < 4; ++i) v[r][i] = *(const float4*)(xr + lane * 4 + 256 * i);
      } else {
        const bf16* xr = p.w.xb + (size_t)row * 1024;
#pragma unroll
        for (int i = 0; i < 4; ++i) v[r][i] = ld_xb4(xr + lane * 4 + 256 * i);
      }
    }
    const float* mod = modrow(p, rb);
    float4 sh[4], sc[4], gg[4];
#pragma unroll
    for (int i = 0; i < 4; ++i) { const int col = lane * 4 + 256 * i; sh[i] = *(const float4*)(mod + col); sc[i] = *(const float4*)(mod + 1024 + col); gg[i] = *(const float4*)(g + col); }
#pragma unroll
    for (int r = 0; r < 4; ++r) {
      const int row = rb + r;
      float ss = 0.f;
#pragma unroll
      for (int i = 0; i < 4; ++i) ss += v[r][i].x * v[r][i].x + v[r][i].y * v[r][i].y + v[r][i].z * v[r][i].z + v[r][i].w * v[r][i].w;
      ss = wave_sum(ss);
      const float rstd = rsqrtf(ss / 1024.f + EPS);
      float hv[16], am = 0.f;
#pragma unroll
      for (int i = 0; i < 4; ++i) {
        hv[i * 4 + 0] = v[r][i].x * rstd * gg[i].x * (1.f + sc[i].x) + sh[i].x; hv[i * 4 + 1] = v[r][i].y * rstd * gg[i].y * (1.f + sc[i].y) + sh[i].y;
        hv[i * 4 + 2] = v[r][i].z * rstd * gg[i].z * (1.f + sc[i].z) + sh[i].z; hv[i * 4 + 3] = v[r][i].w * rstd * gg[i].w * (1.f + sc[i].w) + sh[i].w;
      }
#pragma unroll
      for (int q = 0; q < 16; ++q) am = fmaxf(am, fabsf(hv[q]));
      am = wave_max(am);
      const float qs = am > 0.f ? am * (1.f / 127.f) : 1.f, inv = 1.f / qs;
      if (lane == 0) p.w.sa8[row] = qs;
#pragma unroll
      for (int i = 0; i < 4; ++i) {
        const int q0 = (int)rintf(hv[i * 4] * inv), q1 = (int)rintf(hv[i * 4 + 1] * inv), q2 = (int)rintf(hv[i * 4 + 2] * inv), q3 = (int)rintf(hv[i * 4 + 3] * inv);
        *(unsigned*)(p.w.h8 + (size_t)row * 1024 + lane * 4 + 256 * i) = (unsigned)(q0 & 255) | ((unsigned)(q1 & 255) << 8) | ((unsigned)(q2 & 255) << 16) | ((unsigned)(q3 & 255) << 24);
      }
    }
  }
}

__device__ __forceinline__ void router_prep_phase(const P& p, int bid, int nb, int wv) {
  const int wid = tidx(wv) >> 6, lane = tidx(wv) & 63;
  const float* g = p.norm_ffn_g + p.layer * 1024;
  for (int u = bid * 8 + wid; u < 17 * 32 + 17 * 16; u += nb * 8) {
    if (u < 17 * 32) {
      const int b = u >> 5, ks = u & 31, e = lane & 15, k0 = ks * 32 + (lane >> 4) * 8;
      const float* sc = p.w.mod + ((size_t)p.layer * 17 + b) * 6144 + 4 * 1024;
      unsigned hi[4], lo[4];
#pragma unroll
      for (int jj = 0; jj < 4; ++jj) {
        float m[2]; unsigned short h2[2], l2[2];
#pragma unroll
        for (int q = 0; q < 2; ++q) {
          const int col = k0 + jj * 2 + q;
          m[q] = g[col] * (1.f + sc[col]) * p.router_w[col * 16 + e];
          const bf16 hb = f2bf(m[q]); const float hf32 = bf2f(hb); const bf16 lb = f2bf(m[q] - hf32);
          h2[q] = *(const unsigned short*)&hb; l2[q] = *(const unsigned short*)&lb;
        }
        hi[jj] = (unsigned)h2[0] | ((unsigned)h2[1] << 16); lo[jj] = (unsigned)l2[0] | ((unsigned)l2[1] << 16);
      }
      p.w.mfrag[((size_t)(b * 32 + ks) * 2 + 0) * 64 + lane] = make_uint4(hi[0], hi[1], hi[2], hi[3]);
      p.w.mfrag[((size_t)(b * 32 + ks) * 2 + 1) * 64 + lane] = make_uint4(lo[0], lo[1], lo[2], lo[3]);
    } else {
      const int q = u - 17 * 32, b = q >> 4, e = q & 15;
      const float* sh = p.w.mod + ((size_t)p.layer * 17 + b) * 6144 + 3 * 1024;
      float a = 0.f;
#pragma unroll
      for (int i = 0; i < 16; ++i) { const int col = lane + 64 * i; a += sh[col] * p.router_w[col * 16 + e]; }
      a = wave_sum(a);
      if (lane == 0) p.w.rbias[b * 16 + e] = a;
    }
  }
}

__device__ __forceinline__ void norm_ffn_phase(const P& p, char* shm, int bid, int nb, int wv) {
  float* rstd_l = (float*)shm;
  float* lgs = (float*)(shm + 1024);
  int* lcnt = (int*)(shm + 1024 + 8192);
  int* lbase = lcnt + 32;
  int* rinfo = lbase + 32;
  const int T = tidx(wv), wid = T >> 6, lane = T & 63;
  const int rpb = (p.nrows + nb - 1) / nb;
  const int row0 = bid * rpb;
  const int rend = min(row0 + rpb, p.nrows);
  __syncthreads();
  if (T < 32) lcnt[T] = 0;
  const float* g = p.norm_ffn_g + p.layer * 1024;
  for (int rb = row0 + wid * 4; rb < rend; rb += 32) {
    float4 v[4][4];
#pragma unroll
    for (int r = 0; r < 4; ++r) {
      const int rr = rb + r < rend ? rb + r : rb;
      const bf16* xr = p.w.xb + (size_t)rr * 1024;
#pragma unroll
      for (int i = 0; i < 4; ++i) v[r][i] = ld_xb4(xr + lane * 4 + 256 * i);
    }
    const float* mod = modrow(p, rb);
    float4 sh[4], sc[4], gg[4];
#pragma unroll
    for (int i = 0; i < 4; ++i) { const int col = lane * 4 + 256 * i; sh[i] = *(const float4*)(mod + 3 * 1024 + col); sc[i] = *(const float4*)(mod + 4 * 1024 + col); gg[i] = *(const float4*)(g + col); }
#pragma unroll
    for (int r = 0; r < 4; ++r) {
      const int row = rb + r;
      const bool valid = row < rend;
      float ss = 0.f;
#pragma unroll
      for (int i = 0; i < 4; ++i) ss += v[r][i].x * v[r][i].x + v[r][i].y * v[r][i].y + v[r][i].z * v[r][i].z + v[r][i].w * v[r][i].w;
      ss = wave_sum(ss);
      const float rstd = rsqrtf(ss / 1024.f + EPS);
      float hv[16], am = 0.f;
#pragma unroll
      for (int i = 0; i < 4; ++i) {
        hv[i * 4 + 0] = v[r][i].x * rstd * gg[i].x * (1.f + sc[i].x) + sh[i].x; hv[i * 4 + 1] = v[r][i].y * rstd * gg[i].y * (1.f + sc[i].y) + sh[i].y;
        hv[i * 4 + 2] = v[r][i].z * rstd * gg[i].z * (1.f + sc[i].z) + sh[i].z; hv[i * 4 + 3] = v[r][i].w * rstd * gg[i].w * (1.f + sc[i].w) + sh[i].w;
      }
#pragma unroll
      for (int q = 0; q < 16; ++q) am = fmaxf(am, fabsf(hv[q]));
      am = wave_max(am);
      const float qs = am > 0.f ? am * (1.f / 127.f) : 1.f, inv = 1.f / qs;
      if (valid) {
        if (lane == 0) { p.w.sa8[row] = qs; rstd_l[row - row0] = rstd; }
#pragma unroll
        for (int i = 0; i < 4; ++i) {
          const int q0 = (int)rintf(hv[i * 4] * inv), q1 = (int)rintf(hv[i * 4 + 1] * inv), q2 = (int)rintf(hv[i * 4 + 2] * inv), q3 = (int)rintf(hv[i * 4 + 3] * inv);
          *(unsigned*)(p.w.h8 + (size_t)row * 1024 + lane * 4 + 256 * i) = (unsigned)(q0 & 255) | ((unsigned)(q1 & 255) << 8) | ((unsigned)(q2 & 255) << 16) | ((unsigned)(q3 & 255) << 24);
        }
      }
    }
  }
  __syncthreads();
  for (int t0 = row0 + wid * 16; t0 < rend; t0 += 128) {
    const int bidx = t0 < NLAT ? t0 / SEQ : 16;
    const int ar = min(t0 + (lane & 15), rend - 1);
    const bf16* xa = p.w.xb + (size_t)ar * 1024 + (lane >> 4) * 8;
    const uint4* mf = p.w.mfrag + (size_t)bidx * 32 * 2 * 64 + lane;
    f32x4 acc = f32x4{0.f, 0.f, 0.f, 0.f};
#pragma unroll 8
    for (int ks = 0; ks < 32; ++ks) {
      const bf16x8 a = *(const bf16x8*)(xa + ks * 32);
      const uint4 bh = mf[(ks * 2) * 64], bl = mf[(ks * 2 + 1) * 64];
      acc = __builtin_amdgcn_mfma_f32_16x16x32_bf16(a, __builtin_bit_cast(bf16x8, bh), acc, 0, 0, 0);
      acc = __builtin_amdgcn_mfma_f32_16x16x32_bf16(a, __builtin_bit_cast(bf16x8, bl), acc, 0, 0, 0);
    }
    const float rb_e = p.w.rbias[bidx * 16 + (lane & 15)];
#pragma unroll
    for (int r = 0; r < 4; ++r) {
      const int rr = 4 * (lane >> 4) + r;
      const float rs = rstd_l[min(t0 + rr, rend - 1) - row0];
      lgs[(wid * 16 + rr) * 16 + (lane & 15)] = acc[r] * rs + rb_e;
    }
    __builtin_amdgcn_fence(__ATOMIC_RELEASE, "wavefront");
    if (lane < 16 && t0 + lane < rend) {
      const int row = t0 + lane;
      float sg[16], sb[16];
#pragma unroll
      for (int e = 0; e < 16; ++e) { const float a = lgs[(wid * 16 + lane) * 16 + e]; sg[e] = 1.f / (1.f + expf(-a)); sb[e] = sg[e] + p.router_bias[e]; }
      int gsel = 0; float gbest = -1e30f;
#pragma unroll
      for (int gi = 0; gi < 4; ++gi) {
        float m1 = -1e30f, m2 = -1e30f;
#pragma unroll
        for (int q = 0; q < 4; ++q) { const float t = sb[gi * 4 + q]; if (t > m1) { m2 = m1; m1 = t; } else if (t > m2) m2 = t; }
        const float gs = m1 + m2;
        if (gs > gbest) { gbest = gs; gsel = gi; }
      }
      float vb[4], vs[4];
#pragma unroll
      for (int q = 0; q < 4; ++q) { vb[q] = sb[q]; vs[q] = sg[q]; }
#pragma unroll
      for (int gi = 1; gi < 4; ++gi)
#pragma unroll
        for (int q = 0; q < 4; ++q) if (gsel == gi) { vb[q] = sb[gi * 4 + q]; vs[q] = sg[gi * 4 + q]; }
      int e1 = 0; float b1 = vb[0];
#pragma unroll
      for (int q = 1; q < 4; ++q) if (vb[q] > b1) { b1 = vb[q]; e1 = q; }
      int e2 = -1; float b2 = -1e30f;
#pragma unroll
      for (int q = 0; q < 4; ++q) if (q != e1 && vb[q] > b2) { b2 = vb[q]; e2 = q; }
      const int a = min(e1, e2), b = max(e1, e2);
      float wlo = vs[0], whi = vs[1];
#pragma unroll
      for (int q = 1; q < 4; ++q) { if (a == q) wlo = vs[q]; if (b == q) whi = vs[q]; }
      if (b == 0) whi = vs[0];
      const float nrm = 1.f / (wlo + whi);
      const int pairidx = a == 0 ? b - 1 : (a == 1 ? b + 1 : 5);
      const int cls = gsel * 6 + pairidx;
      p.w.tok_w[row * 2] = wlo * nrm; p.w.tok_w[row * 2 + 1] = whi * nrm;
      const int lr = atomicAdd(&lcnt[cls], 1);
      rinfo[row - row0] = (cls << 16) | lr;
    }
  }
  __syncthreads();
  if (T < 24) lbase[T] = (lcnt[T] && !p.slot) ? atomicAdd(&p.w.cnt[T], lcnt[T]) : 0;
  __syncthreads();
  for (int r = T; r < rend - row0; r += 512) {
    const int info = rinfo[r], cls = info >> 16, lr = info & 0xffff;
    if (!p.slot) p.w.list[(size_t)cls * NALL + lbase[cls] + lr] = row0 + r;
  }
}

struct CvtJob { const float* src; bf16* dst; const float* kscale; long s1, s2, d1, d2; int K, N, ld_dst, nb1, nb2, ks1, rowmap, tile0; };
struct CvtJobs { CvtJob j[8]; int total; int nj; };
__device__ __forceinline__ void cvt_tile(const float* src, int N, bf16* dst, int ld_dst, const float* ks, int rowmap, int k0, int n0, bf16* tile, int wv) {
  const int T = tidx(wv);
  __syncthreads();
#pragma unroll
  for (int i = 0; i < 2; ++i) {
    const int kk = (T >> 4) + i * 32, n4 = (T & 15) * 4;
    const float4 v = *(const float4*)(src + (size_t)(k0 + kk) * N + n0 + n4);
    const float sc = ks ? ks[k0 + kk] : 1.f;
    tile[(n4 + 0) * 72 + kk] = f2bf(v.x * sc); tile[(n4 + 1) * 72 + kk] = f2bf(v.y * sc);
    tile[(n4 + 2) * 72 + kk] = f2bf(v.z * sc); tile[(n4 + 3) * 72 + kk] = f2bf(v.w * sc);
  }
  __syncthreads();
  {
    const int nn = T >> 3, k8 = (T & 7) * 8;
    int drow = n0 + nn;
    if (rowmap) drow = (drow / 192) * 256 + drow % 192;
    *(uint4*)(dst + (size_t)drow * ld_dst + k0 + k8) = *(const uint4*)(tile + nn * 72 + k8);
  }
}
__device__ __forceinline__ void cvt_phase(const CvtJobs& cj, char* shm, int bid, int nb, int wv) {
  bf16* tile = (bf16*)shm;
  for (int t = bid; t < cj.total; t += nb) {
    int ji = 0;
#pragma unroll 1
    for (int q = 1; q < cj.nj; ++q) if (t >= cj.j[q].tile0) ji = q;
    const CvtJob& J = cj.j[ji];
    int lt = t - J.tile0;
    const int tn = J.N / 64, tk = J.K / 64, per = tn * tk;
    const int bi = lt / per; lt -= bi * per;
    const int b1 = bi / J.nb2, b2 = bi % J.nb2;
    const int k0 = (lt / tn) * 64, n0 = (lt % tn) * 64;
    cvt_tile(J.src + b1 * J.s1 + b2 * J.s2, J.N, J.dst + b1 * J.d1 + b2 * J.d2, J.ld_dst, J.kscale ? J.kscale + b1 * J.ks1 : nullptr, J.rowmap, k0, n0, tile, wv);
  }
}
__device__ __forceinline__ void cvt_w13_strip(const float* src, signed char* dst, float* sw, int n0, char* shm, int wv, int ldn = 512) {
  float* cmax = (float*)shm;
  unsigned char* tile8 = (unsigned char*)shm + 8192 + 256;
  const int T = tidx(wv), kq = T >> 4, n4 = (T & 15) * 4;
  float m0 = 0.f, m1 = 0.f, m2 = 0.f, m3 = 0.f;
#pragma unroll 4
  for (int c = 0; c < 32; ++c) {
    const float4 v = *(const float4*)(src + (size_t)(c * 32 + kq) * ldn + n0 + n4);
    m0 = fmaxf(m0, fabsf(v.x)); m1 = fmaxf(m1, fabsf(v.y)); m2 = fmaxf(m2, fabsf(v.z)); m3 = fmaxf(m3, fabsf(v.w));
  }
  __syncthreads();
  *(float4*)(cmax + kq * 64 + n4) = make_float4(m0, m1, m2, m3);
  __syncthreads();
  if (T < 64) {
    float m = 0.f;
#pragma unroll
    for (int q = 0; q < 32; ++q) m = fmaxf(m, cmax[q * 64 + T]);
    const float sc = m > 0.f ? m * (1.f / 127.f) : 1.f;
    sw[n0 + T] = sc;
    cmax[32 * 64 + T] = 1.f / sc;
  }
  __syncthreads();
  const float4 inv = *(const float4*)(cmax + 32 * 64 + n4);
#pragma unroll 1
  for (int k0 = 0; k0 < 1024; k0 += 64) {
#pragma unroll
    for (int i = 0; i < 2; ++i) {
      const int kk = kq + i * 32;
      const float4 v = *(const float4*)(src + (size_t)(k0 + kk) * ldn + n0 + n4);
      tile8[(n4 + 0) * 72 + kk] = (unsigned char)((int)rintf(v.x * inv.x) & 255); tile8[(n4 + 1) * 72 + kk] = (unsigned char)((int)rintf(v.y * inv.y) & 255);
      tile8[(n4 + 2) * 72 + kk] = (unsigned char)((int)rintf(v.z * inv.z) & 255); tile8[(n4 + 3) * 72 + kk] = (unsigned char)((int)rintf(v.w * inv.w) & 255);
    }
    __syncthreads();
    { const int nn = T >> 3, k8 = (T & 7) * 8;
      *(uint2*)(dst + (size_t)(n0 + nn) * 1024 + k0 + k8) = *(const uint2*)(tile8 + nn * 72 + k8); }
    __syncthreads();
  }
}
__device__ __forceinline__ void cvt_strips_phase(const P& p, char* shm, int bid, int nb, int wv) {
  for (int it = bid; it < 150; it += nb) {
    if (it >= 118) {
      const int q = it - 118, j = q >> 4, st = q & 15;
      cvt_w13_strip(p.hy_out_w + (size_t)j * 1024 * 1024, p.w.W_hyout8 + (size_t)j * 1024 * 1024, p.w.s_hyout + j * 1024, st * 64, shm, wv, 1024);
    } else if (it < 96) {
      const int j = it / 48, st = it % 48;
      cvt_w13_strip(p.hy_in_w + (size_t)j * 1024 * 3072, p.w.W_hyin8 + (size_t)j * 3072 * 1024, p.w.s_hyin + j * 3072, st * 64, shm, wv, 3072);
    } else {
      const int q = it - 96, j = q / 11, st = q % 11;
      if (st < 6) cvt_w13_strip(p.mla_wq_down + (size_t)j * 1024 * 384, p.w.W_mdown8 + (size_t)j * 768 * 1024, p.w.s_mdown + j * 768, st * 64, shm, wv, 384);
      else cvt_w13_strip(p.mla_wkv_down + (size_t)j * 1024 * 320, p.w.W_mdown8 + ((size_t)j * 768 + 384) * 1024, p.w.s_mdown + j * 768 + 384, (st - 6) * 64, shm, wv, 320);
    }
  }
}
__device__ __forceinline__ void cvt_moe_phase(const P& p, char* shm, unsigned* queue, int wv) {
  bf16* tile = (bf16*)shm;
  volatile int* slot = (volatile int*)(shm + SHM_SLOT);
  const long HM = 512L * 1024;
  for (;;) {
    __syncthreads();
    if (tidx(wv) == 0) *slot = (int)__hip_atomic_fetch_add(queue, 1u, __ATOMIC_RELAXED, __HIP_MEMORY_SCOPE_AGENT);
    __syncthreads();
    const int it = *slot;
    if (it >= 408) break;
    if (it < 272) {
      const int mat = it >> 3, strip = it & 7, q = mat / 17, e = mat % 17;
      const float* src = q == 0 ? (e < 16 ? p.exp_w1 + ((size_t)p.layer * 16 + e) * HM : p.sh_w1 + (size_t)p.layer * HM)
                                : (e < 16 ? p.exp_w3 + ((size_t)p.layer * 16 + e) * HM : p.sh_w3 + (size_t)p.layer * HM);
      cvt_w13_strip(src, p.w.W13q + ((size_t)e * 2 + q) * HM, p.w.sw13 + (e * 2 + q) * 512, strip * 64, shm, wv);
    } else {
      const int t0 = (it - 272) * 16;
#pragma unroll 1
      for (int t = t0; t < t0 + 16; ++t) {
        const int e = t >> 7, lt = t & 127;
        const float* src = e < 16 ? p.exp_w2 + ((size_t)p.layer * 16 + e) * HM : p.sh_w2 + (size_t)p.layer * HM;
        cvt_tile(src, 1024, p.w.W2 + (size_t)e * HM, 512, nullptr, 0, (lt / 16) * 64, (lt % 16) * 64, tile, wv);
      }
    }
  }
}

constexpr int SHM_MAIN = TOEP_SHM_C;
constexpr int SHM_TOTAL = SHM_MAIN + 32;
static_assert(SHM_SLOT == SHM_MAIN + 16, "slot");
static_assert(SHM_MAIN >= GEMM_SHM && SHM_MAIN >= AT_SHM && SHM_MAIN >= TOEP_SHM, "LDS budget");
struct MP { P p; CvtJobs gj; unsigned* bar; unsigned* pad; };
typedef __attribute__((address_space(4))) const MP* MPK;
__device__ __forceinline__ MPK kargs() { MPK q = (MPK)__builtin_amdgcn_kernarg_segment_ptr(); asm volatile("" : "+s"(q)); return q; }
#if defined(__HIP_DEVICE_COMPILE__)
#define PH(LAYER, NROWS, CALL) do { P p = kargs()->p; p.layer = (LAYER); p.j = (LAYER) >> 1; p.nrows = (NROWS); p.slot = 0; CALL; } while (0)
#define PHD(LAYER, NROWS, CALL) do { P p = kargs()->p; p.layer = (LAYER); p.j = (LAYER) >> 1; p.nrows = (NROWS); p.slot = 1; CALL; } while (0)
#else
#define PHD(LAYER, NROWS, CALL) do { } while (0)
#define PH(LAYER, NROWS, CALL) do { } while (0)
#endif

constexpr int DUP_HYIN = 1, DUP_TOEP = 1, DUP_TR = 1, DUP_MDOWN = 1, DUP_UP = 1, DUP_ATTN = 1, DUP_MOEUP = 1, DUP_NORM = 1, DUP_CVT = 1, DUP_BAR = 0, DUP_PRO = 1, DUP_HYOUT = 1, DUP_WO = 1, DUP_NFFN = 1, DUP_MOEDOWN = 1;

template <int I>
__device__ __forceinline__ void layer_body(char* dynshm, int bid, int nb, const XcdBarrier& bar, int wv) {
  constexpr bool need_ctx = I < 3;
  constexpr int NR = need_ctx ? NALL : NLAT;
  PH(I, NALL, { const int t_ = tidx(wv); if (bid == 0 && t_ < 32) p.w.cnt[t_] = 0; if constexpr ((I & 1) == 1) { for (int q = bid * 512 + t_; q < 2 * NALL; q += nb * 512) p.w.ssq[q] = 0.f; } norm_mix_phase(p, bid, nb, wv); router_prep_phase(p, bid, nb, wv); });
  if constexpr (DUP_NORM > 1) PH(I, NALL, norm_mix_phase(p, bid, nb, wv));
  xcd_barrier(bar, wv);
  if constexpr (DUP_BAR > 0) { for (int q = 0; q < DUP_BAR; ++q) xcd_barrier(bar, wv); }
  if constexpr ((I & 1) == 0) {
    PH(I, NALL, fgemm_phase<F_HYIN>(p, dynshm, bid, nb, wv));
    xcd_barrier(bar, wv);
    if constexpr (DUP_HYIN == 2) { PH(I, NALL, fgemm_phase<F_HYIN>(p, dynshm, bid, nb, wv)); xcd_barrier(bar, wv); }
    if constexpr (DUP_HYIN == 3) { PHD(I, NALL, fgemm_phase<F_HYIN>(p, dynshm, bid, nb, wv)); xcd_barrier(bar, wv); }
    PH(I, NALL, toep_phase(p, dynshm, bid, nb, wv));
    xcd_barrier(bar, wv);
    if constexpr (DUP_TOEP == 2) { PH(I, NALL, toep_phase(p, dynshm, bid, nb, wv)); xcd_barrier(bar, wv); }
    if constexpr (DUP_TOEP == 3) { PHD(I, NALL, toep_phase(p, dynshm, bid, nb, wv)); xcd_barrier(bar, wv); }
    PH(I, NALL, transpose_phase(p, dynshm, bid, nb, wv));
    xcd_barrier(bar, wv);
    if constexpr (DUP_TR > 1) { PH(I, NALL, transpose_phase(p, dynshm, bid, nb, wv)); xcd_barrier(bar, wv); }
    if constexpr (DUP_HYOUT > 1) { PHD(I, NALL, fgemm_phase<F_HYOUT>(p, dynshm, bid, nb, wv)); xcd_barrier(bar, wv); }
    PH(I, NALL, fgemm_phase<F_HYOUT>(p, dynshm, bid, nb, wv));
    PH(I, NALL, cvt_moe_phase(p, dynshm, kargs()->bar + 8 + I, wv));
    xcd_barrier(bar, wv);
  } else {
    PH(I, NALL, fgemm_phase<F_MDOWN>(p, dynshm, bid, nb, wv));
    xcd_barrier(bar, wv);
    if constexpr (DUP_MDOWN > 1) { PH(I, NALL, fgemm_phase<F_MDOWN>(p, dynshm, bid, nb, wv)); xcd_barrier(bar, wv); }
    PH(I, NALL, mla_up_phase(p, dynshm, bid, nb, wv, need_ctx));
    xcd_barrier(bar, wv);
    if constexpr (DUP_UP > 1) { PH(I, NALL, mla_up_phase(p, dynshm, bid, nb, wv, need_ctx)); xcd_barrier(bar, wv); }
    PH(I, NALL, attn_phase(p, dynshm, bid, nb, need_ctx, wv));
    xcd_barrier(bar, wv);
    if constexpr (DUP_ATTN > 1) { PH(I, NALL, attn_phase(p, dynshm, bid, nb, need_ctx, wv)); xcd_barrier(bar, wv); }
    if constexpr (DUP_WO > 1) { PHD(I, NR, fgemm_phase<F_WO>(p, dynshm, bid, nb, wv)); xcd_barrier(bar, wv); }
    PH(I, NR, fgemm_phase<F_WO>(p, dynshm, bid, nb, wv));
    PH(I, NALL, cvt_moe_phase(p, dynshm, kargs()->bar + 8 + I, wv));
    xcd_barrier(bar, wv);
  }
  if constexpr (DUP_NFFN > 1) { PHD(I, NR, norm_ffn_phase(p, dynshm, bid, nb, wv)); xcd_barrier(bar, wv); }
  PH(I, NALL, cvt_moe_phase(p, dynshm, kargs()->bar + 8 + I, wv));
  PH(I, NR, norm_ffn_phase(p, dynshm, bid, nb, wv));
  xcd_barrier(bar, wv);
  PH(I, NR, fmoe_up_phase(p, dynshm, bid, nb, wv));
  xcd_barrier(bar, wv);
  if constexpr (DUP_MOEUP > 1) { PH(I, NR, fmoe_up_phase(p, dynshm, bid, nb, wv)); xcd_barrier(bar, wv); }
  if constexpr (DUP_MOEDOWN > 1) { PHD(I, NR, fmoe_down_phase(p, dynshm, bid, nb, wv)); xcd_barrier(bar, wv); }
  PH(I, NR, fmoe_down_phase(p, dynshm, bid, nb, wv));
  xcd_barrier(bar, wv);
}

__global__ void __launch_bounds__(512, 2) mega(MP mp) {
  extern __shared__ __attribute__((aligned(16))) char dynshm[];
  const int bid = blockIdx.x, nb = gridDim.x;
  const int wv = __builtin_amdgcn_readfirstlane((int)(threadIdx.x >> 6));
  uint4* xbw = (uint4*)(dynshm + SHM_MAIN);
  if (threadIdx.x == 0) *xbw = make_uint4(0u, 0u, 0u, 0u);
  __syncthreads();
  XcdBarrier bar = xcd_barrier_post(mp.bar, (volatile LAS unsigned*)xbw);
  PH(0, NALL, mod_phase(p, dynshm, bid, nb, wv));
  PH(0, NALL, fhid_phase(p, bid, nb, wv));
  PH(0, NALL, ropetab_phase(p, bid, nb, wv));
  cvt_phase(mp.gj, dynshm, bid, nb, wv);
  PH(0, NALL, cvt_strips_phase(p, dynshm, bid, nb, wv));
  xcd_barrier(bar, wv);
  PH(0, NALL, modreduce_phase(p, bid, nb, wv));
  PH(0, NALL, filter_phase(p, dynshm, bid, nb, wv));
  xcd_barrier(bar, wv);
  if constexpr (DUP_PRO == 2) { PH(0, NALL, mod_phase(p, dynshm, bid, nb, wv)); xcd_barrier(bar, wv); }
  if constexpr (DUP_PRO == 3) { PH(0, NALL, fhid_phase(p, bid, nb, wv)); xcd_barrier(bar, wv); }
  if constexpr (DUP_PRO == 4) { cvt_phase(mp.gj, dynshm, bid, nb, wv); xcd_barrier(bar, wv); }
  if constexpr (DUP_PRO == 5) { PH(0, NALL, filter_phase(p, dynshm, bid, nb, wv)); xcd_barrier(bar, wv); }
  layer_body<0>(dynshm, bid, nb, bar, wv);
  layer_body<1>(dynshm, bid, nb, bar, wv);
  layer_body<2>(dynshm, bid, nb, bar, wv);
  layer_body<3>(dynshm, bid, nb, bar, wv);
}

static char* carve(char*& cur, size_t bytes) { char* r = cur; cur += (bytes + 255) / 256 * 256; return r; }

extern "C" void kernel_launch(void* const* d_in, const int* in_sizes, int n_in, void* d_out, int out_size, void* d_ws, size_t ws_size,
                              hipStream_t stream) {
  MP mp{};
  P& p = mp.p;
  const float** fp = (const float**)&p.x;
  for (int i = 0; i < 38; ++i) fp[i] = (const float*)d_in[i];
  p.X = (float*)d_out;
  char* cur = (char*)d_ws;
  WS& w = p.w;
  mp.bar = (unsigned*)carve(cur, XCD_BAR_WORDS * 4);
  w.mod = (float*)carve(cur, (size_t)4 * 17 * 6144 * 4);
  w.xb = (bf16*)carve(cur, (size_t)NALL * 1024 * 2);
  w.h = (bf16*)carve(cur, (size_t)NALL * 1024 * 2);
  w.hf = (float*)carve(cur, (size_t)2 * 2304 * 64 * 4);
  w.rf = (bf16*)carve(cur, (size_t)2 * 1024 * 4608 * 2);
  w.cs = (float*)carve(cur, 64 * 16 * 2 * 4);
  w.cnt = (int*)carve(cur, 32 * 4);
  w.list = (int*)carve(cur, (size_t)24 * NALL * 4);
  w.tok_e = nullptr;
  w.tok_w = (float*)carve(cur, (size_t)NALL * 2 * 4);
  w.W_hyin8 = (signed char*)carve(cur, (size_t)2 * 3072 * 1024);
  w.s_hyin = (float*)carve(cur, (size_t)2 * 3072 * 4);
  w.W_hyout8 = (signed char*)carve(cur, (size_t)2 * 1024 * 1024);
  w.s_hyout = (float*)carve(cur, (size_t)2 * 1024 * 4);
  w.syg = (float*)carve(cur, (size_t)NALL * 4);
  w.W_mdown8 = (signed char*)carve(cur, (size_t)2 * 768 * 1024);
  w.s_mdown = (float*)carve(cur, (size_t)2 * 768 * 4);
  w.W_qup = (bf16*)carve(cur, (size_t)2 * 2048 * 384 * 2);
  w.W_kvup = (bf16*)carve(cur, (size_t)2 * 2048 * 256 * 2);
  w.W_wo = (bf16*)carve(cur, (size_t)2 * 1024 * 1024 * 2);
  w.W13q = (signed char*)carve(cur, (size_t)17 * 2 * 512 * 1024);
  w.sw13 = (float*)carve(cur, (size_t)17 * 2 * 512 * 4);
  w.h8 = (signed char*)carve(cur, (size_t)NALL * 1024);
  w.sa8 = (float*)carve(cur, (size_t)NALL * 4);
  w.mfrag = (uint4*)carve(cur, (size_t)17 * 32 * 2 * 64 * 16);
  w.rbias = (float*)carve(cur, (size_t)17 * 16 * 4);
  w.W2 = (bf16*)carve(cur, (size_t)17 * 1024 * 512 * 2);
  char* R = cur;
  w.zT = (bf16*)carve(cur, (size_t)NALL * 3072 * 2);
  w.ygT = (bf16*)carve(cur, (size_t)NALL * 1024 * 2);
  w.yg = w.zT;
  w.yg8 = (signed char*)w.zT;
  w.un = (float*)w.zT;
  w.modp = (float*)((char*)w.zT + ((size_t)48 << 20));
  char* endH = cur;
  cur = R;
  w.lat = (bf16*)carve(cur, (size_t)NALL * 768 * 2);
  w.ssq = (float*)carve(cur, (size_t)2 * NALL * 4);
  w.q = (bf16*)carve(cur, (size_t)NALL * 1536 * 2);
  w.k = (bf16*)carve(cur, (size_t)NALL * 1536 * 2);
  w.v = (bf16*)carve(cur, (size_t)NALL * 1024 * 2);
  w.o = w.h;
  char* endM = cur;
  cur = R;
  w.hid = (bf16*)carve(cur, (size_t)168 * 256 * 1536 * 2);
  char* endE = cur;
  char* end = endH > endM ? endH : endM; if (endE > end) end = endE;
  if ((size_t)(end - (char*)d_ws) > ws_size) { fprintf(stderr, "ws too small: need %zu have %zu\n", (size_t)(end - (char*)d_ws), ws_size); return; }

  {
    CvtJobs& cj = mp.gj;
    int nj = 0, tiles = 0;
    auto add = [&](const float* src, bf16* dst, const float* ks, int K, int N, int ld_dst, int nb1, int nb2, long s1, long s2, long d1, long d2, int ks1, int rowmap) {
      CvtJob& J = cj.j[nj++];
      J.src = src; J.dst = dst; J.kscale = ks; J.K = K; J.N = N; J.ld_dst = ld_dst; J.nb1 = nb1; J.nb2 = nb2; J.s1 = s1; J.s2 = s2; J.d1 = d1; J.d2 = d2; J.ks1 = ks1; J.rowmap = rowmap;
      J.tile0 = tiles; tiles += nb1 * nb2 * (K / 64) * (N / 64);
    };
    const long M1 = 1024L * 1024;
    add(p.mla_wq_up, w.W_qup, p.mla_q_norm_g, 384, 1536, 384, 2, 1, 384L * 1536, 0, 2048L * 384, 0, 384, 1);
    add(p.mla_wkv_up, w.W_kvup, p.mla_kv_norm_g, 256, 2048, 256, 2, 1, 256L * 2048, 0, 2048L * 256, 0, 256, 0);
    add(p.mla_wo, w.W_wo, nullptr, 1024, 1024, 1024, 2, 1, M1, 0, M1, 0, 0, 0);
    cj.total = tiles; cj.nj = nj;
  }
  static int grid = 0;
  if (!grid) {
    int dev = 0, cus = 0, per_cu = 0;
    hipGetDevice(&dev);
    hipDeviceGetAttribute(&cus, hipDeviceAttributeMultiprocessorCount, dev);
    hipFuncSetAttribute((const void*)mega, hipFuncAttributeMaxDynamicSharedMemorySize, SHM_TOTAL);
    hipOccupancyMaxActiveBlocksPerMultiprocessor(&per_cu, (const void*)mega, 512, SHM_TOTAL);
    if (per_cu < 1) { fprintf(stderr, "mega kernel does not fit on a CU\n"); per_cu = 1; }
    if (cus < 256) fprintf(stderr, "mega kernel needs 256 resident workgroups, device has %d CUs\n", cus);
    grid = 256;
  }
  hipMemsetAsync(mp.bar, 0, XCD_BAR_WORDS * 4, stream);
  hipMemsetAsync(w.W_mdown8, 0, (size_t)2 * 768 * 1024 + 256 + (size_t)2 * 768 * 4, stream);
  hipMemsetAsync(w.W_qup, 0, (size_t)2 * 2048 * 384 * 2, stream);
  hipLaunchKernelGGL(mega, dim3(grid), dim3(512), SHM_TOTAL, stream, mp);
}
```
